# Optimizing an MI355X kernel written in HIP

```python
import math
import jax, jax.numpy as jnp
from jax import lax
import numpy as np

D_MODEL = 1024
BATCH = 2
SEQ = 8192
DEPTH = 4

N_MIXERS = 3
N_A = (DEPTH + 2) // 3
N_B = (DEPTH + 1) // 3
N_C = DEPTH // 3
D_FF = ((8 * D_MODEL // 3 + 127) // 128) * 128
NORM_EPS = 1e-6
SC_WIDTH = 3
HY_SHORT = 3
HY_EMB = 33
HY_BANDS = (HY_EMB - 1) // 2
HY_ORDER = 64
HY_TARGET = 1e-2
HY_FAST_PCT = 0.3
HY_SLOW_PCT = 1.5
HY_MAX_DECAY = math.log(HY_TARGET) / HY_FAST_PCT
HY_MIN_DECAY = math.log(HY_TARGET) / HY_SLOW_PCT
GD_HEADS = 8
GD_DK = D_MODEL // GD_HEADS
GD_DV = D_MODEL // GD_HEADS
GD_CONV = 3
GD_CHUNK = 64
GD_QKV = 2 * GD_HEADS * GD_DK + GD_HEADS * GD_DV

kernel_name = 'hybrid_shortconv_hyena_gdn_encoder'


def rms_norm(x, g):
    xf = x.astype(jnp.float32)
    y = xf * lax.rsqrt(jnp.mean(xf * xf, axis=-1, keepdims=True) + NORM_EPS)
    return (y * g.astype(jnp.float32)).astype(x.dtype)


def centred_dwconv(x, w):
    K = w.shape[0]
    p = K // 2
    L = x.shape[1]
    xp = jnp.pad(x, ((0, 0), (p, p), (0, 0)))
    return sum(xp[:, j:j + L] * w[j] for j in range(K))


def swiglu(x, w_in, w_out):
    g, u = jnp.split(x @ w_in, 2, axis=-1)
    return (jax.nn.silu(g) * u) @ w_out


def short_conv_mixer(x, w_in, conv_w, w_out):
    b, c, h = jnp.split(x @ w_in, 3, axis=-1)
    return (b * centred_dwconv(c * h, conv_w)) @ w_out


def hyena_filters(L, w1, b1, w2, b2, w3, freq):
    f32 = jnp.float32
    t = jnp.linspace(0.0, 1.0, L, dtype=f32)[:, None]
    w = 2.0 * math.pi * jnp.arange(L, dtype=f32)[:, None] / L
    f = jnp.linspace(1e-4, HY_BANDS - 1, HY_BANDS, dtype=f32)[None, :]
    z = jnp.concatenate([t, jnp.cos(f * w), -jnp.sin(f * w)], axis=-1)
    fr = freq.astype(f32)
    h = jnp.sin(fr * (z @ w1.astype(f32) + b1.astype(f32)))
    h = jnp.sin(fr * (h @ w2.astype(f32) + b2.astype(f32)))
    h = h @ w3.astype(f32)
    D = h.shape[-1] // 2
    deltas = jnp.linspace(HY_MIN_DECAY, HY_MAX_DECAY, D, dtype=f32)
    h = h * jnp.exp(-t * jnp.abs(jnp.concatenate([deltas, deltas])))[None] [0]
    return h[:, :D], h[:, D:]


def two_sided_fft_conv(u, h_f, h_b):
    L = u.shape[1]
    zero = jnp.zeros((1, h_f.shape[1]), h_f.dtype)
    h_circ = jnp.concatenate([h_f, zero, h_b[1:][::-1]], axis=0)
    uf = jnp.fft.rfft(u, n=2 * L, axis=1)
    hf = jnp.fft.rfft(h_circ, axis=0)
    return jnp.fft.irfft(uf * hf[None], n=2 * L, axis=1)[:, :L]


def hyena_mixer(x, w_in, b_in, conv_w, conv_b, f_w1, f_b1, f_w2, f_b2, f_w3, f_freq, d_bias, w_out, b_out):
    L = x.shape[1]
    u = centred_dwconv(x @ w_in + b_in, conv_w) + conv_b
    x0, x1, v = jnp.split(u, 3, axis=-1)
    h_f, h_b = hyena_filters(L, f_w1, f_b1, f_w2, f_b2, f_w3, f_freq)
    v = (v * x1).astype(jnp.float32)
    y = two_sided_fft_conv(v, h_f, h_b) + v * d_bias.astype(jnp.float32)
    return (y.astype(x.dtype) * x0) @ w_out + b_out


def chunk_gated_delta_rule(q, k, v, g, beta):
    Bt, L, H, dk = q.shape
    dv = v.shape[-1]
    C = GD_CHUNK
    N = L // C

    def blocks(t):
        t = t.reshape((Bt, N, C, H) + t.shape[3:])
        return jnp.moveaxis(t, 3, 1)

    q, k, v, g, beta = blocks(q), blocks(k), blocks(v), blocks(g), blocks(beta)
    gc = jnp.cumsum(g, axis=-1)
    idx = jnp.arange(C)
    incl = idx[:, None] >= idx[None, :]
    strict = idx[:, None] > idx[None, :]
    decay = jnp.exp(jnp.where(incl, gc[..., :, None] - gc[..., None, :], -jnp.inf))
    kb = k * beta[..., None]
    vb = v * beta[..., None]
    lower = jnp.where(strict, jnp.einsum('bhncd,bhnsd->bhncs', kb, k) * decay, 0.0)
    eye = jnp.eye(C, dtype=q.dtype)
    rhs = jnp.concatenate([vb, kb * jnp.exp(gc)[..., None]], axis=-1)
    sol = lax.linalg.triangular_solve(lower + eye, rhs, left_side=True, lower=True, unit_diagonal=True)
    u, w = sol[..., :dv], sol[..., dv:]
    attn = jnp.einsum('bhncd,bhnsd->bhncs', q, k) * decay
    q_dec = q * jnp.exp(gc)[..., None]
    k_dec = k * jnp.exp(gc[..., -1:] - gc)[..., None]
    g_tot = jnp.exp(gc[..., -1])

    def step(S, inp):
        u_n, w_n, a_n, qd_n, kd_n, gt_n = inp
        v_new = u_n - jnp.einsum('bhcd,bhde->bhce', w_n, S)
        o_n = jnp.einsum('bhcd,bhde->bhce', qd_n, S) + jnp.einsum('bhcs,bhse->bhce', a_n, v_new)
        S = S * gt_n[..., None, None] + jnp.einsum('bhcd,bhce->bhde', kd_n, v_new)
        return S, o_n

    xs = tuple(jnp.moveaxis(t, 2, 0) for t in (u, w, attn, q_dec, k_dec, g_tot))
    S0 = jnp.zeros((Bt, H, dk, dv), jnp.float32)
    _, o = lax.scan(step, S0, xs)
    o = jnp.moveaxis(o, 0, 2)
    return jnp.moveaxis(o, 1, 3).reshape(Bt, L, H, dv)


def l2norm(t):
    return t * lax.rsqrt(jnp.sum(t * t, axis=-1, keepdims=True) + 1e-6)


def gated_deltanet_mixer(x, w_in, conv_w, a_log, dt_bias, norm_g, w_out):
    B, L, _ = x.shape
    H = GD_HEADS
    f32 = jnp.float32
    proj = x @ w_in
    qkv, z, a, b = jnp.split(proj, [GD_QKV, GD_QKV + H * GD_DV, GD_QKV + H * GD_DV + 2 * H], axis=-1)
    qkv = jax.nn.silu(centred_dwconv(qkv, conv_w)).astype(f32)
    q, k, v = jnp.split(qkv, [H * GD_DK, 2 * H * GD_DK], axis=-1)
    q = l2norm(q.reshape(B, L, H, GD_DK)) * (GD_DK ** -0.5)
    k = l2norm(k.reshape(B, L, H, GD_DK))
    v = v.reshape(B, L, H, GD_DV)
    a = a.astype(f32).reshape(B, L, 2, H)
    b = b.astype(f32).reshape(B, L, 2, H)
    g = -jnp.exp(a_log.astype(f32)) * jax.nn.softplus(a + dt_bias.astype(f32))
    beta = jax.nn.sigmoid(b)
    flip = lambda t: jnp.flip(t, axis=1)
    q2 = jnp.concatenate([q, flip(q)], axis=0)
    k2 = jnp.concatenate([k, flip(k)], axis=0)
    v2 = jnp.concatenate([v, flip(v)], axis=0)
    g2 = jnp.concatenate([g[:, :, 0], flip(g[:, :, 1])], axis=0)
    b2 = jnp.concatenate([beta[:, :, 0], flip(beta[:, :, 1])], axis=0)
    o = chunk_gated_delta_rule(q2, k2, v2, g2, b2)
    o = o[:B] + flip(o[B:])
    o = rms_norm(o, norm_g) * jax.nn.silu(z.astype(f32).reshape(B, L, H, GD_DV))
    return o.reshape(B, L, H * GD_DV).astype(x.dtype) @ w_out


def setup_inputs(seed: int = 0) -> dict:
    key = jax.random.key(seed)
    ks = jax.random.split(key, 32)
    f32 = jnp.float32
    D, F, H = D_MODEL, D_FF, GD_HEADS

    def dense(k, shape, fan_in, scale=1.0):
        return jax.random.normal(k, shape, f32) * (scale * fan_in ** -0.5)

    def small(k, shape, scale=0.01):
        return jax.random.normal(k, shape, f32) * scale

    dt = jnp.exp(jax.random.uniform(ks[25], (N_C, 2, H), f32, math.log(1e-3), math.log(1e-1)))
    return {
        'x': jax.random.normal(ks[0], (BATCH, SEQ, D), f32),
        'norms': 1.0 + small(ks[1], (DEPTH, 3, D)),
        'final_norm': 1.0 + small(ks[2], (D,)),
        'ffn_w_in': dense(ks[3], (DEPTH, 2, D, 2 * F), D),
        'ffn_w_out': dense(ks[4], (DEPTH, 2, F, D), F),
        'sc_w_in': dense(ks[5], (N_A, D, 3 * D), D),
        'sc_conv': dense(ks[6], (N_A, SC_WIDTH, D), SC_WIDTH),
        'sc_w_out': dense(ks[7], (N_A, D, D), D),
        'hy_w_in': dense(ks[8], (N_B, D, 3 * D), D),
        'hy_b_in': small(ks[9], (N_B, 3 * D)),
        'hy_conv': dense(ks[10], (N_B, HY_SHORT, 3 * D), HY_SHORT),
        'hy_conv_b': small(ks[11], (N_B, 3 * D)),
        'hy_f_w1': dense(ks[12], (N_B, HY_EMB, HY_ORDER), HY_EMB),
        'hy_f_b1': small(ks[13], (N_B, HY_ORDER), 0.1),
        'hy_f_w2': dense(ks[14], (N_B, HY_ORDER, HY_ORDER), HY_ORDER),
        'hy_f_b2': small(ks[15], (N_B, HY_ORDER), 0.1),
        'hy_f_w3': dense(ks[16], (N_B, HY_ORDER, 2 * D), HY_ORDER, 0.03),
        'hy_f_freq': 1.0 + small(ks[17], (N_B, HY_ORDER)),
        'hy_d': small(ks[18], (N_B, D), 0.5),
        'hy_w_out': dense(ks[19], (N_B, D, D), D),
        'hy_b_out': small(ks[20], (N_B, D)),
        'gd_w_in': dense(ks[21], (N_C, D, GD_QKV + H * GD_DV + 4 * H), D),
        'gd_conv': dense(ks[22], (N_C, GD_CONV, GD_QKV), GD_CONV),
        'gd_a_log': jnp.log(jax.random.uniform(ks[23], (N_C, 2, H), f32, 1.0, 16.0)),
        'gd_dt_bias': dt + jnp.log(-jnp.expm1(-dt)),
        'gd_norm': 1.0 + small(ks[24], (N_C, GD_DV)),
        'gd_w_out': dense(ks[26], (N_C, H * GD_DV, D), H * GD_DV),
    }


def reference(x, norms, final_norm, ffn_w_in, ffn_w_out,
              sc_w_in, sc_conv, sc_w_out,
              hy_w_in, hy_b_in, hy_conv, hy_conv_b, hy_f_w1, hy_f_b1, hy_f_w2, hy_f_b2,
              hy_f_w3, hy_f_freq, hy_d, hy_w_out, hy_b_out,
              gd_w_in, gd_conv, gd_a_log, gd_dt_bias, gd_norm, gd_w_out):
    for i in range(DEPTH):
        m, j = i % N_MIXERS, i // N_MIXERS
        x = x + 0.5 * swiglu(rms_norm(x, norms[i, 0]), ffn_w_in[i, 0], ffn_w_out[i, 0])
        hn = rms_norm(x, norms[i, 1])
        if m == 0:
            y = short_conv_mixer(hn, sc_w_in[j], sc_conv[j], sc_w_out[j])
        elif m == 1:
            y = hyena_mixer(hn, hy_w_in[j], hy_b_in[j], hy_conv[j], hy_conv_b[j],
                            hy_f_w1[j], hy_f_b1[j], hy_f_w2[j], hy_f_b2[j], hy_f_w3[j],
                            hy_f_freq[j], hy_d[j], hy_w_out[j], hy_b_out[j])
        else:
            y = gated_deltanet_mixer(hn, gd_w_in[j], gd_conv[j], gd_a_log[j], gd_dt_bias[j],
                                     gd_norm[j], gd_w_out[j])
        x = x + y
        x = x + 0.5 * swiglu(rms_norm(x, norms[i, 2]), ffn_w_in[i, 1], ffn_w_out[i, 1])
    return rms_norm(x, final_norm)
```

```cpp
#include <hip/hip_runtime.h>
#include <hip/hip_cooperative_groups.h>
#include <cstdio>
#include <cstdint>
namespace cg = cooperative_groups;

#ifndef DUP_MASK
#define DUP_MASK 0
#endif
#ifndef DUP_SCANVAR
#define DUP_SCANVAR 0
#endif
#ifndef DUP_G2
#define DUP_G2 0
#endif
#ifndef DUP_FFT
#define DUP_FFT 0
#endif
#ifndef DUP_BAR
#define DUP_BAR 0
#endif
#ifndef MK_MULTI
#define MK_MULTI 0
#endif

__device__ __forceinline__ int ltid() { int t = threadIdx.x; asm volatile("" : "+v"(t)); return t; }
__device__ __forceinline__ int lbid() { int b = blockIdx.x; asm volatile("" : "+s"(b)); return b; }
namespace pg8 {
#define PG8_LAS __attribute__((address_space(3)))
typedef unsigned short bf16_t;
typedef short bf16x8 __attribute__((ext_vector_type(8)));
typedef float f32x4 __attribute__((ext_vector_type(4)));
typedef unsigned u32x4 __attribute__((ext_vector_type(4)));
constexpr int BM = 256, BK = 64, HALF = 128, HTB = HALF * BK * 2, STAGE_BYTES = 8 * HTB, NXCD = 8, WGM = 8;

__host__ __device__ __forceinline__ int lds_byte(int r, int c) { const int st = (r >> 4) * 2 + (c >> 5), rr = r & 15, cc = c & 31, ob = rr * 64 + cc * 2; return st * 1024 + (ob ^ (((ob >> 9) & 1) << 5)); }
__host__ __device__ __forceinline__ void stage_rc(int b, int& R, int& C) { const int st = b / 1024, sb = b % 1024, swz = sb ^ (((sb >> 9) & 1) << 5); R = (st >> 1) * 16 + swz / 64; C = (st & 1) * 32 + (swz % 64) / 2; }
__host__ __device__ __forceinline__ int perm32(int rho) { const int n = rho >> 4, i = rho & 15; return 8 * (i >> 2) + 4 * n + (i & 3); }

struct Unit { int pm, pn; };
struct Gemm { const bf16_t* A; const bf16_t* Bt; int M, N, K; int lda; size_t kstepA; int ldb; size_t kstepB; };

struct StaticOrder {
    int nM, nN, nwg, G, c;
    __host__ __device__ void init(int M, int N, int G_, int c_) { nM = M / BM; nN = N / BM; nwg = nM * nN; G = G_; c = c_; }
    __host__ __device__ bool next(int i, Unit& u) const {
        const long L = (long)i * G + c; if (L >= nwg) return false;
        int wgid = (int)L; { const int q = nwg / NXCD, r = nwg % NXCD, xcd = wgid % NXCD, off = wgid / NXCD; wgid = (xcd < r ? xcd * (q + 1) : r * (q + 1) + (xcd - r) * q) + off; }
        const int nig = WGM * nN, gid = wgid / nig, fm = gid * WGM, gsz = (nM - fm) < WGM ? (nM - fm) : WGM;
        u.pm = fm + ((wgid % nig) % gsz); u.pn = (wgid % nig) / gsz; return true;
    }
    __device__ __forceinline__ void a_ready(const Unit&) const {}
    __device__ __forceinline__ void done(const Unit&) const {}
};

typedef float f32x2_t __attribute__((ext_vector_type(2))); typedef __bf16 bf16x2_t __attribute__((ext_vector_type(2)));
__device__ __forceinline__ unsigned cvt_pk_bf16(float lo, float hi) { f32x2_t v = {lo, hi}; bf16x2_t b = __builtin_convertvector(v, bf16x2_t); return __builtin_bit_cast(unsigned, b); }

template <class Epi, class Sched, bool ALIGN_EPI = false, bool SP2 = false>
__device__ __forceinline__ void gemm_phase(PG8_LAS unsigned char* lds, const Gemm g, const Sched& S, const Epi& E) {
    const int tid = ltid(), wid = __builtin_amdgcn_readfirstlane(tid >> 6), lane = tid & 63, wr = wid >> 2, wc = wid & 3, fr = lane & 15, fq = lane >> 4;
    const int K = g.K, nt = K / BK;
    unsigned voffA[2], voffB[2];
#pragma unroll
    for (int i = 0; i < 2; ++i) { int R, C; stage_rc(tid * 16 + i * 8192, R, C); const int Rb = Epi::PERM ? ((R & ~31) + perm32(R & 31)) : R;
        voffA[i] = (unsigned)(R * g.lda + C) * 2u; voffB[i] = (unsigned)(Rb * g.ldb + C) * 2u; }
    const size_t kstep = g.kstepB;
    const size_t hstep = (size_t)HALF * g.ldb * 2;
    const size_t tstep = 2 * hstep;
    const size_t kstepA = g.kstepA, hstepA = (size_t)HALF * g.lda * 2, tstepA = 2 * hstepA;
    const unsigned ldsw = (unsigned)wid * 1024u;
    const int aoff = lds_byte(wr * 64 + fr, fq * 8), boff = lds_byte(wc * 32 + fr, fq * 8);
#define PG8_SA(b, h) (((b) * 2 + (h)) * HTB)
#define PG8_SB(b, h) ((4 + (b) * 2 + (h)) * HTB)
#define PG8_STAGE(bufoff, gbase, voff) do { _Pragma("unroll") for (int _i = 0; _i < 2; ++_i) \
        __builtin_amdgcn_global_load_lds((const unsigned*)((const char*)(gbase) + (voff)[_i]), (PG8_LAS unsigned*)(lds + (bufoff) + ldsw + _i * 8192), 16, 0, 0); } while (0)
#define PG8_LDA(dst, b, h) do { _Pragma("unroll") for (int m = 0; m < 4; ++m) _Pragma("unroll") for (int k = 0; k < 2; ++k) dst[m][k] = *(const PG8_LAS bf16x8*)(lds + PG8_SA(b, h) + aoff + m * 2048 + k * 1024); } while (0)
#define PG8_LDB(dst, b, h) do { _Pragma("unroll") for (int n = 0; n < 2; ++n) _Pragma("unroll") for (int k = 0; k < 2; ++k) dst[n][k] = *(const PG8_LAS bf16x8*)(lds + PG8_SB(b, h) + boff + n * 2048 + k * 1024); } while (0)
#define PG8_MMA(ai, bj, At, Bt) do { __builtin_amdgcn_s_setprio(1); _Pragma("unroll") for (int m = 0; m < 4; ++m) _Pragma("unroll") for (int n = 0; n < 2; ++n) _Pragma("unroll") for (int k = 0; k < 2; ++k) \
        acc[ai][bj][m][n] = __builtin_amdgcn_mfma_f32_16x16x32_bf16(Bt[n][k], At[m][k], acc[ai][bj][m][n], 0, 0, 0); __builtin_amdgcn_s_setprio(0); } while (0)
#define PG8_WAIT_V(n) asm volatile("s_waitcnt vmcnt(" #n ")" ::: "memory")
#define PG8_WAIT_L(n) asm volatile("s_waitcnt lgkmcnt(" #n ")" ::: "memory")
#define PG8_BAR __builtin_amdgcn_s_barrier()
#define PG8_SCHED __builtin_amdgcn_sched_barrier(0)
    Unit cur, nxt; int ui = 0;
    if (!S.next(0, cur)) return;
    f32x4 acc[2][2][4][2];
#pragma unroll
    for (int a = 0; a < 2; ++a)
#pragma unroll
        for (int b = 0; b < 2; ++b)
#pragma unroll
            for (int m = 0; m < 4; ++m)
#pragma unroll
                for (int n = 0; n < 2; ++n) acc[a][b][m][n] = (f32x4){0.f, 0.f, 0.f, 0.f};
    bf16x8 At[4][2], B0[2][2], B1[2][2];
    const char* cA = (const char*)g.A + (size_t)cur.pm * tstepA; const char* cB = (const char*)g.Bt + (size_t)cur.pn * tstep;
    if constexpr (Epi::HAS_INIT) E.init(acc, cur, wr, wc, fr, fq);
    S.a_ready(cur);
    if constexpr (SP2) {
        PG8_STAGE(PG8_SB(0, 0), cB, voffB); PG8_STAGE(PG8_SB(0, 1), cB + hstep, voffB); PG8_STAGE(PG8_SA(0, 0), cA, voffA); PG8_STAGE(PG8_SA(0, 1), cA + hstepA, voffA);
        if (wr == 1) PG8_BAR;
        PG8_WAIT_V(2); PG8_BAR;
        PG8_STAGE(PG8_SB(1, 0), cB + kstep, voffB); PG8_STAGE(PG8_SA(1, 0), cA + kstepA, voffA); PG8_STAGE(PG8_SB(1, 1), cB + hstep + kstep, voffB);
        PG8_WAIT_V(6); PG8_BAR;
    } else {
        PG8_STAGE(PG8_SB(0, 0), cB, voffB); PG8_STAGE(PG8_SA(0, 0), cA, voffA); PG8_STAGE(PG8_SB(0, 1), cB + hstep, voffB); PG8_STAGE(PG8_SA(0, 1), cA + hstepA, voffA);
        if (wr == 1) PG8_BAR;
        PG8_WAIT_V(4); PG8_BAR;
        PG8_STAGE(PG8_SB(1, 0), cB + kstep, voffB); PG8_STAGE(PG8_SA(1, 0), cA + kstepA, voffA); PG8_STAGE(PG8_SB(1, 1), cB + hstep + kstep, voffB);
        PG8_WAIT_V(6); PG8_BAR;
    }
    for (;;) {
        const bool has_next = S.next(ui + 1, nxt);
        const char* nA = has_next ? (const char*)g.A + (size_t)nxt.pm * tstepA : cA; const char* nB = has_next ? (const char*)g.Bt + (size_t)nxt.pn * tstep : cB;
        for (int t = 0; t < nt; t += 2) {
            const bool last = (t == nt - 2);
            const char* a1 = cA + (size_t)(t + 1) * kstepA;
            const char* a2 = last ? nA : cA + (size_t)(t + 2) * kstepA; const char* b2 = last ? nB : cB + (size_t)(t + 2) * kstep;
            const char* a3 = a2 + kstepA; const char* b3 = b2 + kstep;
            if (last && has_next) S.a_ready(nxt);
            if constexpr (SP2) {
            PG8_LDB(B0, 0, 0); PG8_LDB(B1, 0, 1); PG8_SCHED; PG8_LDA(At, 0, 0); PG8_STAGE(PG8_SA(1, 1), a1 + hstepA, voffA);
            PG8_WAIT_V(8); PG8_WAIT_L(0); PG8_BAR; PG8_MMA(0, 0, At, B0); PG8_MMA(0, 1, At, B1); PG8_BAR; PG8_SCHED;
            PG8_LDA(At, 0, 1); PG8_STAGE(PG8_SB(0, 0), b2, voffB); PG8_STAGE(PG8_SB(0, 1), b2 + hstep, voffB); PG8_STAGE(PG8_SA(0, 0), a2, voffA);
            PG8_WAIT_V(8); PG8_WAIT_L(0); PG8_BAR; PG8_MMA(1, 0, At, B0); PG8_MMA(1, 1, At, B1); PG8_BAR; PG8_SCHED;
            PG8_LDB(B0, 1, 0); PG8_LDB(B1, 1, 1); PG8_SCHED; PG8_LDA(At, 1, 0); PG8_STAGE(PG8_SA(0, 1), a2 + hstepA, voffA);
            PG8_WAIT_V(8); PG8_WAIT_L(0); PG8_BAR; PG8_MMA(0, 0, At, B0); PG8_MMA(0, 1, At, B1); PG8_BAR; PG8_SCHED;
            PG8_LDA(At, 1, 1); PG8_STAGE(PG8_SB(1, 0), b3, voffB); PG8_STAGE(PG8_SB(1, 1), b3 + hstep, voffB); PG8_STAGE(PG8_SA(1, 0), a3, voffA);
            PG8_WAIT_V(8); PG8_WAIT_L(0); PG8_BAR; PG8_MMA(1, 0, At, B0); PG8_MMA(1, 1, At, B1); PG8_BAR; PG8_SCHED;
            } else {
            PG8_LDB(B0, 0, 0); PG8_SCHED; PG8_LDA(At, 0, 0); PG8_STAGE(PG8_SA(1, 1), a1 + hstepA, voffA);
            PG8_WAIT_L(8); PG8_BAR; PG8_WAIT_L(0); PG8_MMA(0, 0, At, B0); PG8_BAR; PG8_SCHED;
            PG8_LDB(B1, 0, 1); PG8_STAGE(PG8_SB(0, 0), b2, voffB);
            PG8_BAR; PG8_WAIT_L(0); PG8_MMA(0, 1, At, B1); PG8_BAR;
            PG8_LDA(At, 0, 1); PG8_STAGE(PG8_SA(0, 0), a2, voffA);
            PG8_BAR; PG8_WAIT_L(0); PG8_MMA(1, 0, At, B0); PG8_BAR; PG8_SCHED;
            PG8_STAGE(PG8_SB(0, 1), b2 + hstep, voffB);
            PG8_WAIT_V(6); PG8_BAR; PG8_MMA(1, 1, At, B1); PG8_BAR;
            PG8_LDB(B0, 1, 0); PG8_SCHED; PG8_LDA(At, 1, 0); PG8_STAGE(PG8_SA(0, 1), a2 + hstepA, voffA);
            PG8_WAIT_L(8); PG8_BAR; PG8_WAIT_L(0); PG8_MMA(0, 0, At, B0); PG8_BAR; PG8_SCHED;
            PG8_LDB(B1, 1, 1); PG8_STAGE(PG8_SB(1, 0), b3, voffB);
            PG8_BAR; PG8_WAIT_L(0); PG8_MMA(0, 1, At, B1); PG8_BAR;
            PG8_LDA(At, 1, 1); PG8_STAGE(PG8_SA(1, 0), a3, voffA);
            PG8_BAR; PG8_WAIT_L(0); PG8_MMA(1, 0, At, B0); PG8_BAR; PG8_SCHED;
            PG8_STAGE(PG8_SB(1, 1), b3 + hstep, voffB);
            PG8_WAIT_V(6); PG8_BAR; PG8_MMA(1, 1, At, B1); PG8_BAR;
            }
        }
        if constexpr (ALIGN_EPI) { if (wr == 0) PG8_BAR; }
        E(acc, cur, wr, wc, fr, fq, ui);
        if (!has_next) break;
#pragma unroll
        for (int a = 0; a < 2; ++a)
#pragma unroll
            for (int b = 0; b < 2; ++b)
#pragma unroll
                for (int m = 0; m < 4; ++m)
#pragma unroll
                    for (int n = 0; n < 2; ++n) acc[a][b][m][n] = (f32x4){0.f, 0.f, 0.f, 0.f};
        cur = nxt; cA = nA; cB = nB; ++ui;
        if constexpr (Epi::HAS_INIT) E.init(acc, cur, wr, wc, fr, fq);
        if constexpr (ALIGN_EPI) { if (wr == 1) PG8_BAR; }
    }
    PG8_WAIT_V(0);
    if constexpr (!ALIGN_EPI) { if (wr == 0) PG8_BAR; }
    PG8_BAR;
#undef PG8_SA
#undef PG8_SB
#undef PG8_STAGE
#undef PG8_LDA
#undef PG8_LDB
#undef PG8_MMA
#undef PG8_WAIT_V
#undef PG8_WAIT_L
#undef PG8_BAR
#undef PG8_SCHED
}
}

constexpr int D = 1024, SEQ = 8192, NB = 2, M = NB * SEQ, FF = 2816, FF2 = 5632, DEPTH = 4;
constexpr int GH = 8, GDK = 128, GC = 64, GNCH = SEQ / GC;
constexpr int NGD = 4352;
constexpr float NORM_EPS = 1e-6f;
constexpr int NTHR = 512, NWAVES = 8;
constexpr int FFTN = 16384;

typedef unsigned short bf16;
typedef short bf16x8 __attribute__((ext_vector_type(8)));
typedef float f32x4 __attribute__((ext_vector_type(4)));
typedef float f32x2 __attribute__((ext_vector_type(2)));
typedef unsigned u32x4 __attribute__((ext_vector_type(4)));
typedef unsigned u32x2 __attribute__((ext_vector_type(2)));
#define LAS __attribute__((address_space(3)))

constexpr size_t MiB = 1u << 20;
constexpr size_t WS_TW = 0;
constexpr size_t WS_W3T = 65536;
constexpr size_t WS_CTL = 512 * 1024, CTL_BYTES = 16384;
constexpr size_t WS_H2 = 1 * MiB;
constexpr size_t WS_SSQ0 = 3 * MiB, WS_SSQ1 = 171 * MiB;
constexpr size_t WS_WFI = 4 * MiB;
constexpr size_t WS_WFO = 92 * MiB;
constexpr size_t WS_WSI = 136 * MiB;
constexpr size_t WS_WSO = 148 * MiB;
constexpr size_t WS_WHI = 152 * MiB;
constexpr size_t WS_WHO = 158 * MiB;
constexpr size_t WS_WGI = 160 * MiB;
constexpr size_t WS_WGO = 169 * MiB;
constexpr size_t WS_XN = 172 * MiB;
constexpr size_t WS_A2 = 204 * MiB;
constexpr size_t WS_BIG = 236 * MiB;
constexpr size_t BIG_X0 = 96 * MiB;
constexpr size_t BIG_ZT = 128 * MiB;
constexpr size_t BIG_HT = 192 * MiB;
constexpr size_t CH_W = 0, CH_QD = 64 * MiB, CH_KDT = 128 * MiB, CH_UT = 192 * MiB, CH_AT = 256 * MiB;
constexpr size_t BIG_Z = 288 * MiB;
constexpr size_t BIG_AB = 320 * MiB;
constexpr size_t BIG_QKV = 322 * MiB;
constexpr size_t BIG_G = 418 * MiB;
constexpr size_t BIG_GT = 420 * MiB;
constexpr size_t WS_END = WS_BIG + 421 * MiB;

constexpr int LDS_BYTES = 143360;
constexpr int LDS_MISC = LDS_BYTES - 64;

__device__ __forceinline__ float bf2f(unsigned v) { return __uint_as_float(v << 16); }
__device__ __forceinline__ float bflo(unsigned v) { return __uint_as_float(v << 16); }
__device__ __forceinline__ float bfhi(unsigned v) { return __uint_as_float(v & 0xffff0000u); }
__device__ __forceinline__ unsigned pk2(float lo, float hi) { return pg8::cvt_pk_bf16(lo, hi); }
__device__ __forceinline__ float wave_sum(float v) {
#pragma unroll
    for (int o = 1; o < 64; o <<= 1) v += __shfl_xor(v, o);
    return v;
}
__device__ __forceinline__ float silu_f(float x) { return x * __builtin_amdgcn_rcpf(1.f + __expf(-x)); }
__device__ __forceinline__ float sigmoid_f(float x) { return __builtin_amdgcn_rcpf(1.f + __expf(-x)); }


#define XB_TMO      128
#define XB_XCNT(j)  (256  + 64 * (j))
#define XB_XSUB(j)  (1280 + 64 * (j))
#define XB_XGEN(j)  (2304 + 64 * (j))
#define XB_TOP      3328
#define XB_TOPGEN   3392
#define XCD_BAR_WORDS 3456
#define XB_SPIN_CAP (1u << 22)
__device__ __forceinline__ unsigned xb_ld(unsigned* p)              { return __hip_atomic_load(p, __ATOMIC_RELAXED, __HIP_MEMORY_SCOPE_AGENT); }
__device__ __forceinline__ unsigned xb_add(unsigned* p, unsigned v) { return __hip_atomic_fetch_add(p, v, __ATOMIC_RELAXED, __HIP_MEMORY_SCOPE_AGENT); }
__device__ __forceinline__ unsigned xb_xcc_id() { return (unsigned)__builtin_amdgcn_s_getreg((3 << 11) | 20) & 0xFu; }
#define XB_SPIN(cond, bar) do { unsigned _sp = 0; while (cond) { __builtin_amdgcn_s_sleep(1); \
    if ((++_sp & 255u) == 0u) { if (xb_ld(&(bar)[XB_TMO])) break; if (_sp > XB_SPIN_CAP) { atomicAdd(&(bar)[XB_TMO], 1u); break; } } } } while (0)
struct XcdBarrier { unsigned* bar; unsigned x; volatile LAS unsigned* st; };
__device__ __forceinline__ XcdBarrier xcd_barrier_post(unsigned* bar, volatile LAS unsigned* st) {
    XcdBarrier b; b.bar = bar; b.x = xb_xcc_id(); b.st = st;
    if (threadIdx.x == 0) { const unsigned li = xb_add(&bar[XB_XCNT(b.x)], 1u); st[2] = li; st[3] = b.x; }
    return b;
}
__device__ __forceinline__ void xcd_barrier_complete(unsigned* bar, unsigned x, unsigned& nloc, unsigned& nx) {
    const unsigned G = gridDim.x * gridDim.y * gridDim.z;
    unsigned sum, cnt, mine, sp = 0u;
    for (;;) {
        sum = 0u; cnt = 0u; mine = 0u;
#pragma unroll
        for (unsigned j = 0; j < 16; ++j) { const unsigned c = xb_ld(&bar[XB_XCNT(j)]); sum += c; cnt += (c > 0u) ? 1u : 0u; mine = (j == x) ? c : mine; }
        if (sum == G) break;
        __builtin_amdgcn_s_sleep(1);
        if ((++sp & 255u) == 0u) { if (xb_ld(&bar[XB_TMO])) break; if (sp > XB_SPIN_CAP) { atomicAdd(&bar[XB_TMO], 1u); break; } }
    }
    nloc = mine > 0u ? mine : 1u; nx = cnt > 0u ? cnt : 1u;
}
__device__ __forceinline__ void xcd_barrier(const XcdBarrier& b) {
    asm volatile("s_waitcnt vmcnt(0)" ::: "memory");
    __syncthreads();
    if (threadIdx.x == 0) {
        unsigned* bar = b.bar;
        __builtin_amdgcn_s_waitcnt(0);
        unsigned nloc = b.st[0], nx = b.st[1];
        if (nloc == 0u) { xcd_barrier_complete(bar, b.x, nloc, nx); b.st[0] = nloc; b.st[1] = nx; }
        const unsigned old = xb_add(&bar[XB_XSUB(b.x)], 1u);
        const unsigned gen = old / nloc;
        if (old + 1u == (gen + 1u) * nloc) {
            __builtin_amdgcn_fence(__ATOMIC_RELEASE, "agent");
            asm volatile("s_waitcnt vmcnt(0)" ::: "memory");
            const unsigned og = xb_add(&bar[XB_TOP], 1u);
            const unsigned tg = og / nx;
            if (og + 1u == (tg + 1u) * nx) xb_add(&bar[XB_TOPGEN], 1u);
            else XB_SPIN(xb_ld(&bar[XB_TOPGEN]) == tg, bar);
            __builtin_amdgcn_fence(__ATOMIC_ACQUIRE, "agent");
            xb_add(&bar[XB_XGEN(b.x)], 1u);
            asm volatile("s_waitcnt vmcnt(0)" ::: "memory");
        } else {
            XB_SPIN(xb_ld(&bar[XB_XGEN(b.x)]) == gen, bar);
            __builtin_amdgcn_fence(__ATOMIC_ACQUIRE, "agent");
            asm volatile("s_waitcnt vmcnt(0)" ::: "memory");
        }
    }
    __syncthreads();
}

__device__ __forceinline__ float row_rstd(const float* ssq, int row) {
    const f32x4* p = (const f32x4*)(ssq + (size_t)row * 16); const f32x4 a = p[0], b = p[1], c = p[2], d = p[3];
    const f32x4 t = (a + b) + (c + d);
    return rsqrtf(((t[0] + t[1]) + (t[2] + t[3])) * (1.0f / D) + NORM_EPS);
}

struct Params { const float* in[27]; float* out; unsigned char* ws; int ph_lo, ph_hi; };

struct EpiSwiglu {
    static constexpr bool PERM = true, HAS_INIT = false;
    bf16* Hout; const LAS float* rsb;
    __device__ __forceinline__ void operator()(const f32x4 (&acc)[2][2][4][2], const pg8::Unit& u, int wr, int wc, int fr, int fq, int ui) const {
        const int row0 = u.pm * 256 + wr * 64 + fr, col0 = u.pn * 128 + wc * 32 + 8 * fq;
#pragma unroll
        for (int ai = 0; ai < 2; ++ai)
#pragma unroll
            for (int m = 0; m < 4; ++m) {
                const int row = row0 + ai * 128 + m * 16; const float rs = rsb[ui * 256 + (row & 255)];
                bf16* rowp = Hout + ((size_t)(col0 >> 6) * M + row) * 64 + (col0 & 63);
                const f32x4 g0 = acc[ai][0][m][0] * rs, g1 = acc[ai][0][m][1] * rs, u0 = acc[ai][1][m][0] * rs, u1 = acc[ai][1][m][1] * rs;
                u32x4 w;
                w.x = pk2(silu_f(g0[0]) * u0[0], silu_f(g0[1]) * u0[1]); w.y = pk2(silu_f(g0[2]) * u0[2], silu_f(g0[3]) * u0[3]);
                w.z = pk2(silu_f(g1[0]) * u1[0], silu_f(g1[1]) * u1[1]); w.w = pk2(silu_f(g1[2]) * u1[2], silu_f(g1[3]) * u1[3]);
                *(u32x4*)rowp = w;
            }
    }
};
struct EpiResid {
    static constexpr bool PERM = true, HAS_INIT = true;
    bf16* XB; const LAS float* bias; int halfstep; float* ssq;
    __device__ __forceinline__ void init(f32x4 (&acc)[2][2][4][2], const pg8::Unit& u, int wr, int wc, int fr, int fq) const {
        const int row0 = u.pm * 256 + wr * 64 + fr, col0 = u.pn * 256 + wc * 32 + 8 * fq;
        const float ia = halfstep ? 2.0f : 1.0f;
#pragma unroll
        for (int ai = 0; ai < 2; ++ai)
#pragma unroll
            for (int m = 0; m < 4; ++m) { const size_t off = (size_t)(row0 + ai * 128 + m * 16) * D + col0;
#pragma unroll
                for (int bj = 0; bj < 2; ++bj) { const u32x4 x = *(const u32x4*)(XB + off + bj * 128);
                    acc[ai][bj][m][0] = (f32x4){bflo(x.x), bfhi(x.x), bflo(x.y), bfhi(x.y)} * ia; acc[ai][bj][m][1] = (f32x4){bflo(x.z), bfhi(x.z), bflo(x.w), bfhi(x.w)} * ia; } }
    }
    __device__ __forceinline__ void operator()(const f32x4 (&acc)[2][2][4][2], const pg8::Unit& u, int wr, int wc, int fr, int fq, int ui) const {
        const int row0 = u.pm * 256 + wr * 64 + fr, col0 = u.pn * 256 + wc * 32 + 8 * fq;
        const float alpha = halfstep ? 0.5f : 1.0f;
        f32x4 bv[2][2];
#pragma unroll
        for (int bj = 0; bj < 2; ++bj)
#pragma unroll
            for (int n = 0; n < 2; ++n) bv[bj][n] = bias ? *(const LAS f32x4*)(bias + col0 + bj * 128 + 4 * n) : (f32x4){0.f, 0.f, 0.f, 0.f};
#pragma unroll
        for (int ai = 0; ai < 2; ++ai)
#pragma unroll
            for (int m = 0; m < 4; ++m) { const int row = row0 + ai * 128 + m * 16; const size_t off = (size_t)row * D + col0;
                float sq = 0.f;
#pragma unroll
                for (int bj = 0; bj < 2; ++bj) {
                    const f32x4 v0 = (acc[ai][bj][m][0] + bv[bj][0]) * alpha, v1 = (acc[ai][bj][m][1] + bv[bj][1]) * alpha;
                    sq += ((v0[0] * v0[0] + v0[1] * v0[1]) + (v0[2] * v0[2] + v0[3] * v0[3])) + ((v1[0] * v1[0] + v1[1] * v1[1]) + (v1[2] * v1[2] + v1[3] * v1[3]));
                    u32x4 w; w.x = pk2(v0[0], v0[1]); w.y = pk2(v0[2], v0[3]); w.z = pk2(v1[0], v1[1]); w.w = pk2(v1[2], v1[3]);
                    *(u32x4*)(XB + off + bj * 128) = w; }
                sq += __shfl_xor(sq, 16); sq += __shfl_xor(sq, 32);
                if (fq == 0) ssq[(size_t)row * 16 + u.pn * 4 + wc] = sq; }
    }
};
struct EpiProj {
    static constexpr bool PERM = true, HAS_INIT = false;
    bf16* O; int ldc; const float* bias; const LAS float* rsb;
    __device__ __forceinline__ void operator()(const f32x4 (&acc)[2][2][4][2], const pg8::Unit& u, int wr, int wc, int fr, int fq, int ui) const {
        const int row0 = u.pm * 256 + wr * 64 + fr, col0 = u.pn * 256 + wc * 32 + 8 * fq;
        f32x4 bv[2][2];
#pragma unroll
        for (int bj = 0; bj < 2; ++bj)
#pragma unroll
            for (int n = 0; n < 2; ++n) bv[bj][n] = bias ? *(const f32x4*)(bias + col0 + bj * 128 + 4 * n) : (f32x4){0.f, 0.f, 0.f, 0.f};
#pragma unroll
        for (int ai = 0; ai < 2; ++ai)
#pragma unroll
            for (int m = 0; m < 4; ++m) { const int row = row0 + ai * 128 + m * 16; const float rs = rsb[ui * 256 + (row & 255)]; bf16* rowp = O + (size_t)row * ldc + col0;
#pragma unroll
                for (int bj = 0; bj < 2; ++bj) { const f32x4 v0 = acc[ai][bj][m][0] * rs + bv[bj][0], v1 = acc[ai][bj][m][1] * rs + bv[bj][1];
                    u32x4 w; w.x = pk2(v0[0], v0[1]); w.y = pk2(v0[2], v0[3]); w.z = pk2(v1[0], v1[1]); w.w = pk2(v1[2], v1[3]);
                    *(u32x4*)(rowp + bj * 128) = w; } }
    }
};
struct EpiGD {
    static constexpr bool PERM = true, HAS_INIT = false;
    bf16* PJ3; bf16* Z; float* AB; const LAS float* rsb;
    __device__ __forceinline__ void operator()(const f32x4 (&acc)[2][2][4][2], const pg8::Unit& u, int wr, int wc, int fr, int fq, int ui) const {
        const int row0 = u.pm * 256 + wr * 64 + fr;
        if (u.pn < 16) {
            bf16* O; int ldc, col0;
            if (u.pn < 12) { O = PJ3; ldc = 3072; col0 = u.pn * 256 + wc * 32 + 8 * fq; } else { O = Z; ldc = 1024; col0 = (u.pn - 12) * 256 + wc * 32 + 8 * fq; }
#pragma unroll
            for (int ai = 0; ai < 2; ++ai)
#pragma unroll
                for (int m = 0; m < 4; ++m) { const int row = row0 + ai * 128 + m * 16; const float rs = rsb[ui * 256 + (row & 255)]; bf16* rowp = O + (size_t)row * ldc + col0;
#pragma unroll
                    for (int bj = 0; bj < 2; ++bj) { const f32x4 v0 = acc[ai][bj][m][0] * rs, v1 = acc[ai][bj][m][1] * rs;
                        u32x4 w; w.x = pk2(v0[0], v0[1]); w.y = pk2(v0[2], v0[3]); w.z = pk2(v1[0], v1[1]); w.w = pk2(v1[2], v1[3]);
                        *(u32x4*)(rowp + bj * 128) = w; } }
        } else if (wc == 0) {
#pragma unroll
            for (int ai = 0; ai < 2; ++ai)
#pragma unroll
                for (int m = 0; m < 4; ++m) { const int row = row0 + ai * 128 + m * 16; const float rs = rsb[ui * 256 + (row & 255)]; float* rowp = AB + (size_t)row * 32 + 8 * fq;
                    *(f32x4*)rowp = acc[ai][0][m][0] * rs; *(f32x4*)(rowp + 4) = acc[ai][0][m][1] * rs; }
        }
    }
};

__device__ __forceinline__ void transpose_item(const float* W, int K, int N, bf16* WT, int k0, int n0, int drow0, LAS float* scr, int lane, const float* gain, bool kblk) {
    f32x4 v[8];
#pragma unroll
    for (int i = 0; i < 8; ++i) { const int k = k0 + 8 * i + (lane >> 3); v[i] = *(const f32x4*)(W + (size_t)k * N + n0 + 4 * (lane & 7));
        if (gain) v[i] = v[i] * gain[k]; }
#pragma unroll
    for (int i = 0; i < 8; ++i) { LAS float* d = scr + (8 * i + (lane >> 3)) * 33 + 4 * (lane & 7); d[0] = v[i].x; d[1] = v[i].y; d[2] = v[i].z; d[3] = v[i].w; }
    asm volatile("s_waitcnt lgkmcnt(0)" ::: "memory");
    const int c = lane & 7;
#pragma unroll
    for (int j = 0; j < 4; ++j) { const int n = (lane >> 3) + 8 * j; const LAS float* s = scr + (8 * c) * 33 + n;
        u32x4 o; o.x = pk2(s[0 * 33], s[1 * 33]); o.y = pk2(s[2 * 33], s[3 * 33]); o.z = pk2(s[4 * 33], s[5 * 33]); o.w = pk2(s[6 * 33], s[7 * 33]);
        *(u32x4*)(WT + (kblk ? ((size_t)(k0 >> 6) * N + drow0 + n) * 64 + 8 * c : (size_t)(drow0 + n) * K + k0 + 8 * c)) = o; }
    asm volatile("s_waitcnt lgkmcnt(0)" ::: "memory");
}
__device__ __forceinline__ void transpose_job(const float* W, int K, int N, bf16* WT, int item, bool swz, LAS float* scr, int lane, const float* gain = nullptr, bool kblk = false) {
    const int nblk = N / 32, kb = item / nblk, nb = item % nblk, k0 = 64 * kb, n0 = 32 * nb;
    int drow0 = n0;
    if (swz) { const int c = n0 < FF ? n0 : n0 - FF; drow0 = 256 * (c / 128) + (n0 < FF ? 0 : 128) + (c % 128); }
    transpose_item(W, K, N, WT, k0, n0, drow0, scr, lane, gain, kblk);
}

__device__ __forceinline__ void xg_rows(const float* x, const float* g, bf16* xg, float* ssq, int gw, int ngw, int lane) {
    for (int m = gw; m < M; m += ngw) {
        const f32x4* xr = (const f32x4*)(x + (size_t)m * D) + lane;
        f32x4 v[4]; float s = 0.f;
#pragma unroll
        for (int j = 0; j < 4; ++j) { v[j] = xr[64 * j]; s += (v[j].x * v[j].x + v[j].y * v[j].y) + (v[j].z * v[j].z + v[j].w * v[j].w); }
        s = wave_sum(s);
        if (lane < 16) ssq[(size_t)m * 16 + lane] = (lane == 0) ? s : 0.f;
        u32x2* o = (u32x2*)(xg + (size_t)m * D) + lane;
#pragma unroll
        for (int j = 0; j < 4; ++j) { const f32x4 y = v[j]; u32x2 w; w.x = pk2(y.x, y.y); w.y = pk2(y.z, y.w); o[64 * j] = w; }
    }
}
__device__ __forceinline__ void final_rows(const bf16* xb, float* out, const float* g, const float* ssq, int gw, int ngw, int lane) {
    for (int m = gw; m < M; m += ngw) {
        const float rs = row_rstd(ssq, m);
        const u32x2* xr = (const u32x2*)(xb + (size_t)m * D) + lane; f32x4* orow = (f32x4*)(out + (size_t)m * D) + lane;
        u32x2 v[4];
#pragma unroll
        for (int j = 0; j < 4; ++j) v[j] = xr[64 * j];
#pragma unroll
        for (int j = 0; j < 4; ++j) { const f32x4 gg = *((const f32x4*)g + lane + 64 * j); orow[64 * j] = (f32x4){bflo(v[j].x), bfhi(v[j].x), bflo(v[j].y), bfhi(v[j].y)} * rs * gg; }
    }
}

constexpr int I_FI = (D / 64) * (FF2 / 32), I_FO = (FF / 64) * (D / 32), I_SI = (D / 64) * (3 * D / 32), I_DD = (D / 64) * (D / 32), I_GI = (D / 64) * (4128 / 32);
constexpr int T0 = 8 * I_FI, T1 = T0 + 8 * I_FO, T2 = T1 + 2 * I_SI, T3 = T2 + 2 * I_DD, T4 = T3 + I_SI, T5 = T4 + I_DD, T6 = T5 + I_GI, T7 = T6 + I_DD;
__device__ __forceinline__ void convert_item(const Params& P, int it, LAS float* scr, int lane) {
    unsigned char* ws = P.ws;
    if (it < T0) { const int mi = it / I_FI, r = it % I_FI; transpose_job(P.in[3] + (size_t)mi * D * FF2, D, FF2, (bf16*)(ws + WS_WFI) + (size_t)mi * FF2 * D, r, true, scr, lane, P.in[1] + (size_t)(3 * (mi >> 1) + 2 * (mi & 1)) * D); }
    else if (it < T1) { const int q = it - T0, mi = q / I_FO, r = q % I_FO; transpose_job(P.in[4] + (size_t)mi * FF * D, FF, D, (bf16*)(ws + WS_WFO) + (size_t)mi * D * FF, r, false, scr, lane, nullptr, true); }
    else if (it < T2) { const int q = it - T1, mi = q / I_SI, r = q % I_SI; transpose_job(P.in[5] + (size_t)mi * D * 3 * D, D, 3 * D, (bf16*)(ws + WS_WSI) + (size_t)mi * 3 * D * D, r, false, scr, lane, P.in[1] + (size_t)(9 * mi + 1) * D); }
    else if (it < T3) { const int q = it - T2, mi = q / I_DD, r = q % I_DD; transpose_job(P.in[7] + (size_t)mi * D * D, D, D, (bf16*)(ws + WS_WSO) + (size_t)mi * D * D, r, false, scr, lane); }
    else if (it < T4) { transpose_job(P.in[8], D, 3 * D, (bf16*)(ws + WS_WHI), it - T3, false, scr, lane, P.in[1] + (size_t)4 * D); }
    else if (it < T5) { transpose_job(P.in[19], D, D, (bf16*)(ws + WS_WHO), it - T4, false, scr, lane); }
    else if (it < T6) { transpose_job(P.in[21], D, 4128, (bf16*)(ws + WS_WGI), it - T5, false, scr, lane, P.in[1] + (size_t)7 * D); }
    else { transpose_job(P.in[26], D, D, (bf16*)(ws + WS_WGO), it - T6, false, scr, lane); }
}
__device__ __forceinline__ int layer_item_count(int L) { return 2 * I_FI + 2 * I_FO + (L == 2 ? I_GI + I_DD : I_SI + I_DD); }
__device__ __forceinline__ int layer_item(int L, int k) {
    if (k < 2 * I_FI) return 2 * L * I_FI + k;
    k -= 2 * I_FI;
    if (k < 2 * I_FO) return T0 + 2 * L * I_FO + k;
    k -= 2 * I_FO;
    if (L == 1) return T3 + k;
    if (L == 2) return T5 + k;
    const int j = (L == 3) ? 1 : 0;
    return (k < I_SI) ? T1 + j * I_SI + k : T2 + j * I_DD + (k - I_SI);
}
__device__ __forceinline__ void convert_tail(const Params& P, unsigned char* lds, int L, int part) {
    const int tid = ltid(), lane = tid & 63, wave = tid >> 6, c = lbid();
    if (c < 128) return;
    LAS float* scr = (LAS float*)((LAS unsigned char*)lds + wave * 16384);
    const int cnt = layer_item_count(L), lo = part ? cnt / 2 : 0, hi = part ? cnt : cnt / 2;
    for (int k = lo + (c - 128) * NWAVES + wave; k < hi; k += 128 * NWAVES) convert_item(P, layer_item(L, k), scr, lane);
}

__device__ __forceinline__ void prologue(const Params& P, unsigned char* lds, int G) {
    const int tid = ltid(), lane = tid & 63, wave = tid >> 6;
    const int gw = lbid() * NWAVES + wave, ngw = G * NWAVES;
    unsigned char* ws = P.ws;
    LAS float* scr = (LAS float*)((LAS unsigned char*)lds + wave * 16384);
    if (G == 256) { const int cnt = layer_item_count(0); for (int k = gw; k < cnt; k += ngw) convert_item(P, layer_item(0, k), scr, lane); }
    else { for (int it = gw; it < T7; it += ngw) convert_item(P, it, scr, lane); }
    for (int k = lbid() * NTHR + tid; k < FFTN / 2; k += G * NTHR) {
        float s, c; sincospif((float)k * (1.0f / 8192.0f), &s, &c);
        ((f32x2*)(ws + WS_TW))[k] = (f32x2){c, -s};
    }
    {
        const float* w1 = P.in[12]; const float* b1 = P.in[13]; const float* w2 = P.in[14]; const float* b2 = P.in[15]; const float* fr = P.in[17];
        bf16* H2 = (bf16*)(ws + WS_H2);
        const float frq = fr[lane], bb1 = b1[lane], bb2 = b2[lane];
        for (int t = gw; t < SEQ; t += ngw) {
            const float tt = (float)t * (1.0f / (float)(SEQ - 1));
            const float w = (6.283185307179586f * (float)t) / (float)SEQ;
            float z = 0.f;
            if (lane == 0) z = tt;
            else if (lane <= 32) { const int e = (lane - 1) & 15; const float f = 1e-4f + (float)e * ((15.0f - 1e-4f) / 15.0f); const float a = f * w; z = (lane <= 16) ? cosf(a) : -sinf(a); }
            float h1 = bb1;
            for (int e = 0; e < 33; ++e) h1 += __shfl(z, e) * w1[e * 64 + lane];
            h1 = sinf(frq * h1);
            float h2 = bb2;
            for (int j = 0; j < 64; ++j) h2 += __shfl(h1, j) * w2[j * 64 + lane];
            h2 = sinf(frq * h2);
            H2[t * 64 + lane] = (bf16)(pk2(h2, 0.f) & 0xffffu);
        }
        for (int i = lbid() * NTHR + tid; i < 2 * D * 64; i += G * NTHR) { const int c = i >> 6, k = i & 63; ((bf16*)(ws + WS_W3T))[i] = (bf16)(pk2(P.in[16][(size_t)k * (2 * D) + c], 0.f) & 0xffffu); }
    }
    xg_rows(P.in[0], P.in[1], (bf16*)(ws + WS_XN), (float*)(ws + WS_SSQ0), gw, ngw, lane);
}

__device__ __forceinline__ void unpack8(const u32x4 a, float (&o)[8]) { o[0] = bflo(a.x); o[1] = bfhi(a.x); o[2] = bflo(a.y); o[3] = bfhi(a.y); o[4] = bflo(a.z); o[5] = bfhi(a.z); o[6] = bflo(a.w); o[7] = bfhi(a.w); }
__device__ __forceinline__ void mul8(const u32x4 a, const u32x4 b, float (&o)[8]) {
    o[0] = bflo(a.x) * bflo(b.x); o[1] = bfhi(a.x) * bfhi(b.x); o[2] = bflo(a.y) * bflo(b.y); o[3] = bfhi(a.y) * bfhi(b.y);
    o[4] = bflo(a.z) * bflo(b.z); o[5] = bfhi(a.z) * bfhi(b.z); o[6] = bflo(a.w) * bflo(b.w); o[7] = bfhi(a.w) * bfhi(b.w);
}
__device__ __forceinline__ void sc_ew(const bf16* PJ, const float* cw, bf16* A2, int G) {
    const int tid = ltid(), d = 8 * (tid & 127), grp = tid >> 7;
    float w0[8], w1[8], w2[8];
#pragma unroll
    for (int i = 0; i < 8; ++i) { w0[i] = cw[d + i]; w1[i] = cw[D + d + i]; w2[i] = cw[2 * D + d + i]; }
    for (int item = lbid(); item < M / 64; item += G) {
        const int m0 = item * 64 + grp * 16, t0 = m0 % SEQ;
        float p[8], c[8], n[8];
        if (t0 > 0) mul8(*(const u32x4*)(PJ + (size_t)(m0 - 1) * 3072 + 1024 + d), *(const u32x4*)(PJ + (size_t)(m0 - 1) * 3072 + 2048 + d), p);
        else {
#pragma unroll
            for (int i = 0; i < 8; ++i) p[i] = 0.f; }
        mul8(*(const u32x4*)(PJ + (size_t)m0 * 3072 + 1024 + d), *(const u32x4*)(PJ + (size_t)m0 * 3072 + 2048 + d), c);
#pragma unroll 4
        for (int r = 0; r < 16; ++r) {
            const int m = m0 + r;
            if (t0 + r + 1 < SEQ) mul8(*(const u32x4*)(PJ + (size_t)(m + 1) * 3072 + 1024 + d), *(const u32x4*)(PJ + (size_t)(m + 1) * 3072 + 2048 + d), n);
            else {
#pragma unroll
                for (int i = 0; i < 8; ++i) n[i] = 0.f; }
            const u32x4 bb = *(const u32x4*)(PJ + (size_t)m * 3072 + d);
            float y[8];
#pragma unroll
            for (int i = 0; i < 8; ++i) y[i] = w0[i] * p[i] + w1[i] * c[i] + w2[i] * n[i];
            u32x4 o;
            o.x = pk2(bflo(bb.x) * y[0], bfhi(bb.x) * y[1]); o.y = pk2(bflo(bb.y) * y[2], bfhi(bb.y) * y[3]); o.z = pk2(bflo(bb.z) * y[4], bfhi(bb.z) * y[5]); o.w = pk2(bflo(bb.w) * y[6], bfhi(bb.w) * y[7]);
            *(u32x4*)(A2 + (size_t)m * D + d) = o;
#pragma unroll
            for (int i = 0; i < 8; ++i) { p[i] = c[i]; c[i] = n[i]; }
        }
    }
}

__device__ __forceinline__ void hy_filter(const bf16* H2, const bf16* w3t, float* hT, int G) {
    const int tid = ltid(), lane = tid & 63, wave = tid >> 6, row = lane & 15, quad = lane >> 4;
    const int gw = lbid() * NWAVES + wave, ngw = G * NWAVES;
    constexpr float MIN_DECAY = -3.0701134573253943f, MAX_DECAY = -15.350567286626972f;
    for (int task = gw; task < (SEQ / 16) * (2 * D / 128); task += ngw) {
        const int t0 = (task % (SEQ / 16)) * 16, cb0 = (task / (SEQ / 16)) * 128;
        const bf16x8 a0 = *(const bf16x8*)(H2 + (size_t)(t0 + row) * 64 + 8 * quad), a1 = *(const bf16x8*)(H2 + (size_t)(t0 + row) * 64 + 32 + 8 * quad);
        float tt[4];
#pragma unroll
        for (int j = 0; j < 4; ++j) tt[j] = (float)(t0 + 4 * quad + j) * (1.0f / (float)(SEQ - 1));
#pragma unroll
        for (int ct = 0; ct < 8; ++ct) {
            const int c = cb0 + 16 * ct + row;
            const bf16x8 b0 = *(const bf16x8*)(w3t + (size_t)c * 64 + 8 * quad), b1 = *(const bf16x8*)(w3t + (size_t)c * 64 + 32 + 8 * quad);
            f32x4 acc = {0.f, 0.f, 0.f, 0.f};
            acc = __builtin_amdgcn_mfma_f32_16x16x32_bf16(a0, b0, acc, 0, 0, 0);
            acc = __builtin_amdgcn_mfma_f32_16x16x32_bf16(a1, b1, acc, 0, 0, 0);
            const float ad = fabsf(MIN_DECAY + (float)(c & (D - 1)) * ((MAX_DECAY - MIN_DECAY) / (float)(D - 1)));
            f32x4 o;
#pragma unroll
            for (int j = 0; j < 4; ++j) o[j] = acc[j] * expf(-tt[j] * ad);
            *(f32x4*)(hT + (size_t)c * SEQ + t0 + 4 * quad) = o;
        }
    }
}
__device__ __forceinline__ void hy_ew1(const bf16* PJ, const float* cw, const float* cb, bf16* X0, unsigned* ZT, unsigned char* lds, int G) {
    const int tid = ltid(), dl = tid & 15, tg = tid >> 4;
    LAS float* zs = (LAS float*)lds;
    for (int item = lbid(); item < (SEQ / 64) * (D / 128); item += G) {
        const int t0 = (item % (SEQ / 64)) * 64, d0 = (item / (SEQ / 64)) * 128, d = d0 + 8 * dl;
        __syncthreads();
#pragma unroll
        for (int b = 0; b < 2; ++b) {
            float r[3][2][8];
#pragma unroll
            for (int s_ = 0; s_ < 3; ++s_) {
                float u[4][8];
#pragma unroll
                for (int i = 0; i < 4; ++i) { const int t = t0 + 2 * tg + i - 1; const bool ok = (t >= 0) && (t < SEQ);
                    if (ok) unpack8(*(const u32x4*)(PJ + ((size_t)b * SEQ + t) * 3072 + s_ * D + d), u[i]);
                    else {
#pragma unroll
                        for (int e = 0; e < 8; ++e) u[i][e] = 0.f; } }
#pragma unroll
                for (int e = 0; e < 8; ++e) { const float w0 = cw[s_ * D + d + e], w1 = cw[3 * D + s_ * D + d + e], w2 = cw[6 * D + s_ * D + d + e], bb = cb[s_ * D + d + e];
                    r[s_][0][e] = w0 * u[0][e] + w1 * u[1][e] + w2 * u[2][e] + bb; r[s_][1][e] = w0 * u[1][e] + w1 * u[2][e] + w2 * u[3][e] + bb; }
            }
#pragma unroll
            for (int i = 0; i < 2; ++i) {
                const size_t m = (size_t)b * SEQ + t0 + 2 * tg + i;
                u32x4 w; w.x = pk2(r[0][i][0], r[0][i][1]); w.y = pk2(r[0][i][2], r[0][i][3]); w.z = pk2(r[0][i][4], r[0][i][5]); w.w = pk2(r[0][i][6], r[0][i][7]);
                *(u32x4*)(X0 + m * D + d) = w;
                LAS float* zp = zs + (b * 64 + 2 * tg + i) * 129 + 8 * dl;
#pragma unroll
                for (int e = 0; e < 8; ++e) zp[e] = r[2][i][e] * r[1][i][e];
            }
        }
        __syncthreads();
        const int tl = tid & 63, dg = tid >> 6;
#pragma unroll
        for (int i = 0; i < 16; ++i) { const int dd = 16 * dg + i; ZT[(size_t)(d0 + dd) * SEQ + t0 + tl] = pk2(zs[tl * 129 + dd], zs[(64 + tl) * 129 + dd]); }
    }
}
__device__ __forceinline__ void hy_ew2(const unsigned* ZT, const bf16* X0, bf16* A2, unsigned char* lds, int G) {
    const int tid = ltid();
    LAS float* ys = (LAS float*)lds;
    for (int item = lbid(); item < (SEQ / 64) * (D / 128); item += G) {
        const int t0 = (item % (SEQ / 64)) * 64, d0 = (item / (SEQ / 64)) * 128;
        __syncthreads();
        { const int tl = tid & 63, dg = tid >> 6;
#pragma unroll
          for (int i = 0; i < 16; ++i) { const int dd = 16 * dg + i; const unsigned y = ZT[(size_t)(d0 + dd) * SEQ + t0 + tl]; ys[tl * 129 + dd] = bflo(y); ys[(64 + tl) * 129 + dd] = bfhi(y); } }
        __syncthreads();
        { const int dl = tid & 63, tg = tid >> 6;
#pragma unroll
          for (int b = 0; b < 2; ++b)
#pragma unroll
            for (int i = 0; i < 8; ++i) { const size_t m = (size_t)b * SEQ + t0 + 8 * tg + i; const unsigned x0 = *(const unsigned*)(X0 + m * D + d0 + 2 * dl);
                const LAS float* yp = ys + (b * 64 + 8 * tg + i) * 129 + 2 * dl;
                *(unsigned*)(A2 + m * D + d0 + 2 * dl) = pk2(yp[0] * bflo(x0), yp[1] * bfhi(x0)); } }
    }
}

__device__ __forceinline__ f32x2 cmul(f32x2 a, f32x2 b) { return (f32x2){a.x * b.x - a.y * b.y, a.x * b.y + a.y * b.x}; }
__device__ __forceinline__ f32x2 cmulc(f32x2 a, f32x2 b) { return (f32x2){a.x * b.x + a.y * b.y, a.y * b.x - a.x * b.y}; }
__device__ __forceinline__ constexpr float w16c(int i) { return i == 0 ? 1.f : i == 1 ? 0.9238795325112867f : i == 2 ? 0.7071067811865476f : i == 3 ? 0.3826834323650898f : i == 4 ? 0.f : i == 5 ? -0.3826834323650898f : i == 6 ? -0.7071067811865476f : -0.9238795325112867f; }
__device__ __forceinline__ constexpr float w16s(int i) { return i == 0 ? 0.f : i == 1 ? -0.3826834323650898f : i == 2 ? -0.7071067811865476f : i == 3 ? -0.9238795325112867f : i == 4 ? -1.f : i == 5 ? -0.9238795325112867f : i == 6 ? -0.7071067811865476f : -0.3826834323650898f; }
__device__ __forceinline__ int fpad(int i) { return i + (i >> 5); }

template <int R> struct Log2 { static constexpr int v = 1 + Log2<R / 2>::v; };
template <> struct Log2<1> { static constexpr int v = 0; };

template <int R, bool INV, bool UNIT>
__device__ __forceinline__ void bfly(f32x2 (&v)[R], f32x2 base) {
    constexpr int Q = Log2<R>::v;
    f32x2 bp[Q];
    bp[0] = base;
#pragma unroll
    for (int q = 1; q < Q; ++q) bp[q] = cmul(bp[q - 1], bp[q - 1]);
    if constexpr (!INV) {
#pragma unroll
        for (int q = 0; q < Q; ++q) { const int half = R >> (q + 1);
#pragma unroll
            for (int blk = 0; blk < R; blk += 2 * half)
#pragma unroll
                for (int i = 0; i < half; ++i) { const int idx = blk + i; const f32x2 a = v[idx], c = v[idx + half]; v[idx] = a + c; f32x2 dd = a - c;
                    const int ci = i * (8 / half);
                    if (ci != 0) dd = cmul(dd, (f32x2){w16c(ci), w16s(ci)});
                    if (!UNIT) dd = cmul(dd, bp[q]);
                    v[idx + half] = dd; } }
    } else {
#pragma unroll
        for (int q = Q - 1; q >= 0; --q) { const int half = R >> (q + 1);
#pragma unroll
            for (int blk = 0; blk < R; blk += 2 * half)
#pragma unroll
                for (int i = 0; i < half; ++i) { const int idx = blk + i; const f32x2 a = v[idx]; f32x2 c = v[idx + half];
                    const int ci = i * (8 / half);
                    if (ci != 0) c = cmulc(c, (f32x2){w16c(ci), w16s(ci)});
                    if (!UNIT) c = cmulc(c, bp[q]);
                    v[idx] = a + c; v[idx + half] = a - c; } }
    }
}
template <int R, int HP, bool INV>
__device__ __forceinline__ void fft_pass(LAS f32x2* X, const f32x2 base, int tid) {
    constexpr int NBF = FFTN / R;
#pragma unroll 1
    for (int id = tid; id < NBF; id += NTHR) {
        const int j = id & (HP - 1), blk = id / HP, p0 = blk * (R * HP) + j;
        f32x2 v[R];
#pragma unroll
        for (int m = 0; m < R; ++m) v[m] = X[fpad(p0 + m * HP)];
        bfly<R, INV, false>(v, base);
#pragma unroll
        for (int m = 0; m < R; ++m) X[fpad(p0 + m * HP)] = v[m];
    }
}

template <bool STORE> __device__ __forceinline__ void hy_fft(const float* hT, const float* dbias, unsigned* ZT, const f32x2* TW, unsigned char* lds, int G) {
    const int tid = ltid();
    LAS f32x2* X = (LAS f32x2*)lds;
    const f32x2 twA0 = TW[tid], twA1 = TW[tid + NTHR], twB = TW[(tid & 63) * 16], twC = TW[(tid & 7) * 256];
    for (int d = lbid(); d < D; d += G) {
        f32x2 Hf[4][8];
        __syncthreads();
#pragma unroll 1
        for (int r = 0; r < 2; ++r) { const int j = tid + NTHR * r; f32x2 v[16];
#pragma unroll
            for (int m = 0; m < 16; ++m) { const int p = j + m * 1024; float val;
                if (m < 8) { val = hT[(size_t)d * SEQ + p]; if (p == 0) val += dbias[d]; }
                else if (p == SEQ) val = 0.f;
                else val = hT[(size_t)(D + d) * SEQ + (2 * SEQ - p)];
                v[m] = (f32x2){val, 0.f}; }
            bfly<16, false, false>(v, r ? twA1 : twA0);
#pragma unroll
            for (int m = 0; m < 16; ++m) X[fpad(j + m * 1024)] = v[m]; }
        __syncthreads();
        fft_pass<16, 64, false>(X, twB, tid); __syncthreads();
        fft_pass<8, 8, false>(X, twC, tid); __syncthreads();
#pragma unroll
        for (int r = 0; r < 4; ++r) { const int id = tid + NTHR * r; f32x2 v[8];
#pragma unroll
            for (int m = 0; m < 8; ++m) v[m] = X[fpad(id * 8 + m)];
            bfly<8, false, true>(v, (f32x2){1.f, 0.f});
#pragma unroll
            for (int m = 0; m < 8; ++m) Hf[r][m] = v[m] * (1.0f / (float)FFTN); }
        __syncthreads();
#pragma unroll 1
        for (int r = 0; r < 2; ++r) { const int j = tid + NTHR * r; f32x2 v[16];
#pragma unroll
            for (int m = 0; m < 16; ++m) { if (m < 8) { const unsigned z = ZT[(size_t)d * SEQ + j + m * 1024]; v[m] = (f32x2){bflo(z), bfhi(z)}; } else v[m] = (f32x2){0.f, 0.f}; }
            bfly<16, false, false>(v, r ? twA1 : twA0);
#pragma unroll
            for (int m = 0; m < 16; ++m) X[fpad(j + m * 1024)] = v[m]; }
        __syncthreads();
        fft_pass<16, 64, false>(X, twB, tid); __syncthreads();
        fft_pass<8, 8, false>(X, twC, tid); __syncthreads();
#pragma unroll
        for (int r = 0; r < 4; ++r) { const int id = tid + NTHR * r; f32x2 v[8];
#pragma unroll
            for (int m = 0; m < 8; ++m) v[m] = X[fpad(id * 8 + m)];
            bfly<8, false, true>(v, (f32x2){1.f, 0.f});
#pragma unroll
            for (int m = 0; m < 8; ++m) v[m] = cmul(v[m], Hf[r][m]);
            bfly<8, true, true>(v, (f32x2){1.f, 0.f});
#pragma unroll
            for (int m = 0; m < 8; ++m) X[fpad(id * 8 + m)] = v[m]; }
        __syncthreads();
        fft_pass<8, 8, true>(X, twC, tid); __syncthreads();
        fft_pass<16, 64, true>(X, twB, tid); __syncthreads();
#pragma unroll 1
        for (int r = 0; r < 2; ++r) { const int j = tid + NTHR * r; f32x2 v[16];
#pragma unroll
            for (int m = 0; m < 16; ++m) v[m] = X[fpad(j + m * 1024)];
            bfly<16, true, false>(v, r ? twA1 : twA0);
#pragma unroll
            for (int m = 0; m < 8; ++m) if (STORE || v[m].x == 123.456f) ZT[(size_t)d * SEQ + j + m * 1024] = pk2(v[m].x, v[m].y); }
    }
}

__device__ __forceinline__ void gd_prep(const bf16* PJ3, const float* AB, const float* cw, const float* alog, const float* dtb, bf16* QKV, float* Gd, float* Bd, int G) {
    const int tid = ltid(), lane = tid & 63, wave = tid >> 6;
    const int gw = lbid() * NWAVES + wave, ngw = G * NWAVES;
    for (int task = gw; task < (M / 8) * GH; task += ngw) {
        const int h = task & 7, m0 = (task >> 3) * 8, t0 = m0 % SEQ;
        float wgt[3][3][2]; unsigned prv[3], cur[3];
#pragma unroll
        for (int s = 0; s < 3; ++s) { const int col = s * D + h * GDK + 2 * lane;
#pragma unroll
            for (int j = 0; j < 3; ++j) { wgt[s][j][0] = cw[j * 3072 + col]; wgt[s][j][1] = cw[j * 3072 + col + 1]; }
            prv[s] = (t0 > 0) ? *(const unsigned*)(PJ3 + (size_t)(m0 - 1) * 3072 + col) : 0u;
            cur[s] = *(const unsigned*)(PJ3 + (size_t)m0 * 3072 + col); }
#pragma unroll 4
        for (int r = 0; r < 8; ++r) {
            const int m = m0 + r; unsigned nxt[3]; float o[3][2];
#pragma unroll
            for (int s = 0; s < 3; ++s) { const int col = s * D + h * GDK + 2 * lane;
                nxt[s] = (t0 + r + 1 < SEQ) ? *(const unsigned*)(PJ3 + (size_t)(m + 1) * 3072 + col) : 0u;
                o[s][0] = silu_f(wgt[s][0][0] * bflo(prv[s]) + wgt[s][1][0] * bflo(cur[s]) + wgt[s][2][0] * bflo(nxt[s]));
                o[s][1] = silu_f(wgt[s][0][1] * bfhi(prv[s]) + wgt[s][1][1] * bfhi(cur[s]) + wgt[s][2][1] * bfhi(nxt[s]));
                prv[s] = cur[s]; cur[s] = nxt[s]; }
            const float sq = wave_sum(o[0][0] * o[0][0] + o[0][1] * o[0][1]), sk = wave_sum(o[1][0] * o[1][0] + o[1][1] * o[1][1]);
            const float rq = rsqrtf(sq + 1e-6f) * 0.08838834764831845f, rk = rsqrtf(sk + 1e-6f);
            const size_t off = (size_t)m * D + h * GDK + 2 * lane;
            *(unsigned*)(QKV + off) = pk2(o[0][0] * rq, o[0][1] * rq);
            *(unsigned*)(QKV + (size_t)M * D + off) = pk2(o[1][0] * rk, o[1][1] * rk);
            *(unsigned*)(QKV + 2 * (size_t)M * D + off) = pk2(o[2][0], o[2][1]);
        }
    }
    for (int i = lbid() * NTHR + tid; i < M * 16; i += G * NTHR) {
        const int m = i >> 4, e = i & 15, dir = e >> 3, h = e & 7;
        const float a = AB[(size_t)m * 32 + e], b = AB[(size_t)m * 32 + 16 + e];
        const float xx = a + dtb[e];
        const float sp = xx > 20.f ? xx : log1pf(expf(xx));
        Gd[((size_t)dir * M + m) * 8 + h] = -expf(alog[e]) * sp;
        Bd[((size_t)dir * M + m) * 8 + h] = 1.f / (1.f + expf(-b));
    }
}

__device__ __forceinline__ int gd_token(int dir, int b, int p) { return b * SEQ + (dir ? (SEQ - 1 - p) : p); }

__device__ __forceinline__ void lds_barrier() { asm volatile("s_waitcnt lgkmcnt(0)" ::: "memory"); __builtin_amdgcn_s_barrier(); asm volatile("" ::: "memory"); }

__device__ __forceinline__ void gd_chunk(const bf16* QKV, const float* Gd, const float* Bd, unsigned char* big, unsigned char* lds_, int G) {
    const int tid = ltid(), lane = tid & 63, wave = __builtin_amdgcn_readfirstlane(tid >> 6), row = lane & 15, quad = lane >> 4;
    LAS unsigned char* lds = (LAS unsigned char*)lds_;
    constexpr int RS = 136, AST = 72, XST = 72;
    LAS bf16* qs = (LAS bf16*)lds; LAS bf16* ks = qs + 64 * RS; LAS bf16* vs = ks + 64 * RS;
    LAS float* As = (LAS float*)(lds + 3 * 64 * RS * 2);
    LAS float* gcs = As + 64 * 68;
    LAS float* bes = gcs + 64;
    LAS bf16* Asb = (LAS bf16*)(bes + 64);
    LAS bf16* Xt = Asb + 64 * AST;
    LAS float* Cw = (LAS float*)(Xt + 256 * XST) + (wave & 3) * (16 * 65);
    bf16* Wc = (bf16*)(big + CH_W); bf16* QD = (bf16*)(big + CH_QD); bf16* KDT = (bf16*)(big + CH_KDT); bf16* UT = (bf16*)(big + CH_UT); bf16* AT = (bf16*)(big + CH_AT);
    float* GT = (float*)(big + BIG_GT);
    constexpr int NCID = 2 * NB * GH * GNCH;
    u32x4 pf[6]; float gpre = 0.f, bpre = 0.f;
#define CHUNK_PREFETCH(cid_) do { const int n_ = (cid_) & (GNCH - 1), h_ = ((cid_) >> 7) & 7, b_ = ((cid_) >> 10) & 1, dir_ = (cid_) >> 11; \
        _Pragma("unroll") for (int i_ = 0; i_ < 6; ++i_) { const int e_ = tid + NTHR * i_, s_ = e_ >> 10, r_ = (e_ >> 4) & 63, pc_ = e_ & 15; const int m_ = gd_token(dir_, b_, 64 * n_ + r_); \
            pf[i_] = *(const u32x4*)(QKV + (size_t)s_ * M * D + (size_t)m_ * D + h_ * GDK + pc_ * 8); } \
        if (tid < 64) { const int m_ = gd_token(dir_, b_, 64 * n_ + tid); gpre = Gd[((size_t)dir_ * M + m_) * 8 + h_]; bpre = Bd[((size_t)dir_ * M + m_) * 8 + h_]; } } while (0)
    if (lbid() < NCID) CHUNK_PREFETCH(lbid());
    for (int cid = lbid(); cid < NCID; cid += G) {
        lds_barrier();
#pragma unroll
        for (int i = 0; i < 6; ++i) { const int e = tid + NTHR * i, s_ = e >> 10, r = (e >> 4) & 63, pc = e & 15; *(LAS u32x4*)(qs + s_ * 64 * RS + r * RS + pc * 8) = pf[i]; }
        if (tid < 64) { float g = gpre;
#pragma unroll
            for (int o = 1; o < 64; o <<= 1) { const float t = __shfl_up(g, o); if (lane >= o) g += t; }
            gcs[tid] = g; bes[tid] = bpre;
            if (tid == 63) GT[cid] = __expf(g); }
        lds_barrier();
        if (cid + G < NCID) CHUNK_PREFETCH(cid + G);
        { const int mt = wave & 3, nt0 = 2 * (wave >> 2);
          f32x4 kk[2] = {{0.f, 0.f, 0.f, 0.f}, {0.f, 0.f, 0.f, 0.f}}, qk[2] = {{0.f, 0.f, 0.f, 0.f}, {0.f, 0.f, 0.f, 0.f}};
#pragma unroll
          for (int kst = 0; kst < 4; ++kst) {
              const bf16x8 ak = *(const LAS bf16x8*)(ks + (16 * mt + row) * RS + 32 * kst + 8 * quad), aq = *(const LAS bf16x8*)(qs + (16 * mt + row) * RS + 32 * kst + 8 * quad);
#pragma unroll
              for (int nn = 0; nn < 2; ++nn) { const bf16x8 bk = *(const LAS bf16x8*)(ks + (16 * (nt0 + nn) + row) * RS + 32 * kst + 8 * quad);
                  kk[nn] = __builtin_amdgcn_mfma_f32_16x16x32_bf16(ak, bk, kk[nn], 0, 0, 0); qk[nn] = __builtin_amdgcn_mfma_f32_16x16x32_bf16(aq, bk, qk[nn], 0, 0, 0); } }
#pragma unroll
          for (int nn = 0; nn < 2; ++nn)
#pragma unroll
              for (int j = 0; j < 4; ++j) { const int c = 16 * mt + 4 * quad + j, s_ = 16 * (nt0 + nn) + row;
                  const float dg = (s_ <= c) ? (gcs[c] - gcs[s_]) : 0.f; const float dec = __expf(dg);
                  const float av = (s_ < c) ? bes[c] * kk[nn][j] * dec : 0.f;
                  As[s_ * 68 + c] = av;
                  Asb[c * AST + s_] = (bf16)(pk2(av, 0.f) & 0xffffu);
                  AT[(size_t)cid * 4096 + (((c >> 4) * 2 + (s_ >> 5)) * 64 + (c & 15) + 16 * ((s_ & 31) >> 3)) * 8 + (s_ & 7)] = (bf16)(pk2((s_ <= c) ? qk[nn][j] * dec : 0.f, 0.f) & 0xffffu); } }
        if (tid < 256) {
#pragma unroll
            for (int i = 0; i < 8; ++i) *(LAS u32x4*)(Xt + tid * XST + 8 * i) = (u32x4){0u, 0u, 0u, 0u}; }
        lds_barrier();
        if (tid < 256) {
            const int col = tid; const bool isw = col >= 128; const LAS bf16* src = isw ? (ks + (col - 128)) : (vs + col);
#pragma unroll 1
            for (int blk = 0; blk < 4; ++blk) {
                float R[16];
#pragma unroll
                for (int r = 0; r < 16; ++r) { const int c = 16 * blk + r; float a = bf2f(src[c * RS]) * bes[c]; if (isw) a *= __expf(gcs[c]); R[r] = a; }
                if (blk > 0) {
#pragma unroll
                    for (int ct = 0; ct < 4; ++ct) {
                        f32x4 acc = {0.f, 0.f, 0.f, 0.f};
                        { const bf16x8 a0 = *(const LAS bf16x8*)(Asb + (16 * blk + row) * AST + 8 * quad), b0 = *(const LAS bf16x8*)(Xt + (64 * wave + 16 * ct + row) * XST + 8 * quad);
                          acc = __builtin_amdgcn_mfma_f32_16x16x32_bf16(a0, b0, acc, 0, 0, 0); }
                        if (blk == 3) { const bf16x8 a1 = *(const LAS bf16x8*)(Asb + (16 * blk + row) * AST + 32 + 8 * quad), b1 = *(const LAS bf16x8*)(Xt + (64 * wave + 16 * ct + row) * XST + 32 + 8 * quad);
                          acc = __builtin_amdgcn_mfma_f32_16x16x32_bf16(a1, b1, acc, 0, 0, 0); }
#pragma unroll
                        for (int j = 0; j < 4; ++j) Cw[(4 * quad + j) * 65 + 16 * ct + row] = acc[j];
                    }
                    asm volatile("s_waitcnt lgkmcnt(0)" ::: "memory");
#pragma unroll
                    for (int r = 0; r < 16; ++r) R[r] -= Cw[r * 65 + lane];
                }
#pragma unroll
                for (int sl = 0; sl < 15; ++sl) {
                    const float xs = R[sl];
                    const LAS f32x4* ap = (const LAS f32x4*)(As + (16 * blk + sl) * 68 + 16 * blk);
                    f32x4 av[4];
#pragma unroll
                    for (int q = 0; q < 4; ++q) if (4 * q + 3 > sl) av[q] = ap[q];
#pragma unroll
                    for (int r = sl + 1; r < 16; ++r) R[r] -= av[r >> 2][r & 3] * xs;
                }
                u32x4 w0, w1;
                w0.x = pk2(R[0], R[1]); w0.y = pk2(R[2], R[3]); w0.z = pk2(R[4], R[5]); w0.w = pk2(R[6], R[7]);
                w1.x = pk2(R[8], R[9]); w1.y = pk2(R[10], R[11]); w1.z = pk2(R[12], R[13]); w1.w = pk2(R[14], R[15]);
                if (blk < 3) { *(LAS u32x4*)(Xt + col * XST + 16 * blk) = w0; *(LAS u32x4*)(Xt + col * XST + 16 * blk + 8) = w1; asm volatile("s_waitcnt lgkmcnt(0)" ::: "memory"); }
                if (!isw) {
                    bf16* up = UT + (size_t)cid * 8192 + (((col >> 4) * 4 + blk) * 64 + (col & 15)) * 4;
                    *(u32x2*)up = (u32x2){w0.x, w0.y}; *(u32x2*)(up + 64) = (u32x2){w0.z, w0.w}; *(u32x2*)(up + 128) = (u32x2){w1.x, w1.y}; *(u32x2*)(up + 192) = (u32x2){w1.z, w1.w};
                } else {
                    const int dk = col - 128;
                    bf16* wp = Wc + (size_t)cid * 8192 + ((blk * 4 + (dk >> 5)) * 64 + 16 * ((dk & 31) >> 3)) * 8 + (dk & 7);
#pragma unroll
                    for (int r = 0; r < 16; ++r) wp[r * 8] = (bf16)(pk2(R[r], 0.f) & 0xffffu);
                }
            }
        } else {
            const int t2 = tid - 256;
#pragma unroll
            for (int i = 0; i < 4; ++i) { const int pc = t2 + 256 * i, c = pc >> 4, d8 = (pc & 15) * 8; const float e = __expf(gcs[c]);
                const u32x4 qv = *(const LAS u32x4*)(qs + c * RS + d8); u32x4 w;
                w.x = pk2(bflo(qv.x) * e, bfhi(qv.x) * e); w.y = pk2(bflo(qv.y) * e, bfhi(qv.y) * e); w.z = pk2(bflo(qv.z) * e, bfhi(qv.z) * e); w.w = pk2(bflo(qv.w) * e, bfhi(qv.w) * e);
                *(u32x4*)(QD + (size_t)cid * 8192 + (((c >> 4) * 4 + (d8 >> 5)) * 64 + (c & 15) + 16 * ((d8 & 31) >> 3)) * 8) = w; }
            const int dk = t2 & 127, chf = t2 >> 7; const float glast = gcs[63];
#pragma unroll
            for (int c8 = 0; c8 < 4; ++c8) { float x[8];
#pragma unroll
                for (int q = 0; q < 8; ++q) { const int c = 32 * chf + 8 * c8 + q; x[q] = bf2f(ks[c * RS + dk]) * __expf(glast - gcs[c]); }
                u32x4 w; w.x = pk2(x[0], x[1]); w.y = pk2(x[2], x[3]); w.z = pk2(x[4], x[5]); w.w = pk2(x[6], x[7]);
                *(u32x4*)(KDT + (size_t)cid * 8192 + (((dk >> 4) * 2 + chf) * 64 + (dk & 15) + 16 * c8) * 8) = w; }
        }
    }
#undef CHUNK_PREFETCH
}

struct ScanStage { bf16x8 P[4], A[2], K[2]; u32x2 u; };
__device__ __forceinline__ void scan_load(ScanStage& s, const bf16* Pm, const bf16* AT, const bf16* KDT, const bf16* UT, size_t cid, int mt, int wave, int slice, int row, int quad) {
    const int lane = row + 16 * quad;
#pragma unroll
    for (int k = 0; k < 4; ++k) s.P[k] = *(const bf16x8*)(Pm + cid * 8192 + ((mt * 4 + k) * 64 + lane) * 8);
#pragma unroll
    for (int k = 0; k < 2; ++k) s.K[k] = *(const bf16x8*)(KDT + cid * 8192 + ((wave * 2 + k) * 64 + lane) * 8);
    if (wave < 4) s.u = *(const u32x2*)(UT + cid * 8192 + ((slice * 4 + mt) * 64 + lane) * 4);
    else {
#pragma unroll
        for (int k = 0; k < 2; ++k) s.A[k] = *(const bf16x8*)(AT + cid * 4096 + ((mt * 2 + k) * 64 + lane) * 8); }
}
template <int VAR> __device__ __forceinline__ void scan_step(const ScanStage& s, float gt, f32x4& Sacc, LAS bf16* St, LAS bf16* Vt, bf16* Orow0, int ostride, bool lead, int mt, int wave, int row, int quad) {
    constexpr int SS = 136, VS = 72;
    f32x4 acc = {0.f, 0.f, 0.f, 0.f};
#pragma unroll
    for (int k = 0; k < 4; ++k) { const bf16x8 sb = *(const LAS bf16x8*)(St + row * SS + 32 * k + 8 * quad); acc = __builtin_amdgcn_mfma_f32_16x16x32_bf16(s.P[k], sb, acc, 0, 0, 0); }
    if (lead) {
        const float v0 = bflo(s.u.x) - acc[0], v1 = bfhi(s.u.x) - acc[1], v2 = bflo(s.u.y) - acc[2], v3 = bfhi(s.u.y) - acc[3];
        u32x2 w; w.x = pk2(v0, v1); w.y = pk2(v2, v3);
        *(LAS u32x2*)(Vt + row * VS + 16 * mt + 4 * quad) = w;
    }
    lds_barrier();
    bf16x8 vb[2];
#pragma unroll
    for (int k = 0; k < 2; ++k) vb[k] = *(const LAS bf16x8*)(Vt + row * VS + 32 * k + 8 * quad);
    if (!lead) {
#pragma unroll
        for (int k = 0; k < 2; ++k) acc = __builtin_amdgcn_mfma_f32_16x16x32_bf16(s.A[k], vb[k], acc, 0, 0, 0);
#pragma unroll
        for (int j = 0; j < 4; ++j) if (VAR == 0) Orow0[(ptrdiff_t)(4 * quad + j) * ostride] = (bf16)(pk2(acc[j], 0.f) & 0xffffu);
        if (VAR != 0) Sacc += acc * 1e-30f;
    }
    Sacc = Sacc * gt;
#pragma unroll
    for (int k = 0; k < 2; ++k) Sacc = __builtin_amdgcn_mfma_f32_16x16x32_bf16(s.K[k], vb[k], Sacc, 0, 0, 0);
    { u32x2 w; w.x = pk2(Sacc[0], Sacc[1]); w.y = pk2(Sacc[2], Sacc[3]); *(LAS u32x2*)(St + row * SS + 16 * wave + 4 * quad) = w; }
    lds_barrier();
}
template <int VAR> __device__ __forceinline__ void gd_scan(unsigned char* big, bf16* O, unsigned char* lds_, int G, unsigned* ctl) {
    const int tid = ltid(), lane = tid & 63, wave = __builtin_amdgcn_readfirstlane(tid >> 6), row = lane & 15, quad = lane >> 4;
    LAS unsigned char* lds = (LAS unsigned char*)lds_;
    constexpr int SS = 136;
    LAS bf16* St = (LAS bf16*)lds; LAS bf16* Vt = St + 16 * SS; LAS float* gts = (LAS float*)(lds + 8192);
    const bf16* Wc = (const bf16*)(big + CH_W); const bf16* QD = (const bf16*)(big + CH_QD); const bf16* KDT = (const bf16*)(big + CH_KDT); const bf16* UT = (const bf16*)(big + CH_UT); const bf16* AT = (const bf16*)(big + CH_AT);
    const float* GT = (const float*)(big + BIG_GT);
    const int mt = wave & 3; const bool lead = wave < 4;
    int t0 = lbid(), tstride = G;
    { volatile LAS unsigned* misc = (volatile LAS unsigned*)(lds + LDS_MISC); const unsigned li = misc[2], xc = misc[3]; bool ok = (G == 256) && xc < 8u && li < 32u;
#pragma unroll
      for (int j = 0; j < 8; ++j) ok = ok && (xb_ld(&ctl[XB_XCNT(j)]) == 32u);
      if (ok) { t0 = (int)((li << 3) | xc); tstride = 256; } }
    for (int task = t0; task < 2 * NB * GH * 8; task += tstride) {
        const int slice = (task >> 3) & 7, chain = (task & 7) * 4 + (task >> 6), h = chain & 7, b = (chain >> 3) & 1, dir = chain >> 4;
        __syncthreads();
        for (int e = tid; e < 16 * SS; e += NTHR) St[e] = 0;
        if (tid < GNCH) gts[tid] = GT[(size_t)((task & 7) * 4 + (task >> 6)) * GNCH + tid];
        f32x4 Sacc = {0.f, 0.f, 0.f, 0.f};
        __syncthreads();
        const bf16* Pm = lead ? Wc : QD;
        const size_t cid0 = (VAR == 3) ? (size_t)0 : (size_t)chain * GNCH;
        const int ostride = dir ? -D : D;
        bf16* Obase = O + ((size_t)dir * M + gd_token(dir, b, 16 * mt)) * D + h * GDK + slice * 16 + row;
        ScanStage s0, s1, s2;
        scan_load(s0, Pm, AT, KDT, UT, cid0 + 0, mt, wave, slice, row, quad);
        scan_load(s1, Pm, AT, KDT, UT, cid0 + 1, mt, wave, slice, row, quad);
        scan_load(s2, Pm, AT, KDT, UT, cid0 + 2, mt, wave, slice, row, quad);
#pragma unroll 1
        for (int n = 0; n < GNCH - 2; n += 3) {
            const int n3 = (n + 3 < GNCH - 2) ? n + 3 : GNCH - 3;
            scan_step<VAR>(s0, gts[n + 0], Sacc, St, Vt, Obase + (ptrdiff_t)(64 * (n + 0)) * ostride, ostride, lead, mt, wave, row, quad);
            if (VAR != 1) scan_load(s0, Pm, AT, KDT, UT, cid0 + n3 + 0, mt, wave, slice, row, quad);
            scan_step<VAR>(s1, gts[n + 1], Sacc, St, Vt, Obase + (ptrdiff_t)(64 * (n + 1)) * ostride, ostride, lead, mt, wave, row, quad);
            if (VAR != 1) scan_load(s1, Pm, AT, KDT, UT, cid0 + n3 + 1, mt, wave, slice, row, quad);
            scan_step<VAR>(s2, gts[n + 2], Sacc, St, Vt, Obase + (ptrdiff_t)(64 * (n + 2)) * ostride, ostride, lead, mt, wave, row, quad);
            if (VAR != 1) scan_load(s2, Pm, AT, KDT, UT, cid0 + n3 + 2, mt, wave, slice, row, quad);
        }
        scan_step<VAR>(s1, gts[GNCH - 2], Sacc, St, Vt, Obase + (ptrdiff_t)(64 * (GNCH - 2)) * ostride, ostride, lead, mt, wave, row, quad);
        scan_step<VAR>(s2, gts[GNCH - 1], Sacc, St, Vt, Obase + (ptrdiff_t)(64 * (GNCH - 1)) * ostride, ostride, lead, mt, wave, row, quad);
        if (VAR != 0 && Sacc[0] == 123.456f) ctl[4000] = 1u;
    }
}

__device__ __forceinline__ void gd_post(const bf16* O, const bf16* Z, const float* ng, bf16* A2, int G) {
    const int tid = ltid(), lane = tid & 63, wave = tid >> 6;
    const int gw = lbid() * NWAVES + wave, ngw = G * NWAVES;
    const float g0 = ng[2 * lane], g1 = ng[2 * lane + 1];
#pragma unroll 4
    for (int task = gw; task < M * GH; task += ngw) {
        const int m = task >> 3, h = task & 7; const size_t off = (size_t)m * D + h * GDK + 2 * lane;
        const unsigned a = *(const unsigned*)(O + off), bq = *(const unsigned*)(O + (size_t)M * D + off), z = *(const unsigned*)(Z + off);
        const float o0 = bflo(a) + bflo(bq), o1 = bfhi(a) + bfhi(bq);
        const float rstd = rsqrtf(wave_sum(o0 * o0 + o1 * o1) * (1.f / GDK) + NORM_EPS);
        *(unsigned*)(A2 + off) = pk2(o0 * rstd * g0 * silu_f(bflo(z)), o1 * rstd * g1 * silu_f(bfhi(z)));
    }
}

constexpr int LDS_RS = 131072;
__device__ __forceinline__ void rs_prefill(const pg8::StaticOrder& S, const float* ssq, unsigned char* lds) {
    const int tid = ltid(); LAS float* rsb = (LAS float*)((LAS unsigned char*)lds + LDS_RS);
    pg8::Unit u;
    for (int i = 0; i < 6 && S.next(i, u); ++i) {
        const int r = tid >> 1; const f32x4* p = (const f32x4*)(ssq + (size_t)(u.pm * 256 + r) * 16 + (tid & 1) * 8);
        const f32x4 a = p[0], b = p[1]; float t = ((a[0] + a[1]) + (a[2] + a[3])) + ((b[0] + b[1]) + (b[2] + b[3]));
        t += __shfl_xor(t, 1);
        if ((tid & 1) == 0) rsb[i * 256 + r] = rsqrtf(t * (1.0f / D) + NORM_EPS);
    }
    __syncthreads();
}

__device__ __forceinline__ void vec_prefill(const float* gain, const float* bias, unsigned char* lds) {
    const int tid = ltid(); LAS float* t = (LAS float*)((LAS unsigned char*)lds + LDS_RS);
    for (int i = tid; i < D; i += NTHR) { t[i] = gain[i]; t[D + i] = bias ? bias[i] : 0.f; }
    __syncthreads();
}

constexpr int N_PHASES = 35;
enum { T_PRO = 0, T_G1, T_G2, T_NORM, T_PJ, T_SCEW, T_RES, T_HYEW1, T_HYFFT, T_HYEW2, T_GDPJ, T_GDPREP, T_GDCHUNK, T_GDSCAN, T_GDPOST };

__device__ __forceinline__ int run_phase(int ph, const Params& P, unsigned char* lds, int G_) {
    int G = G_; asm volatile("" : "+s"(G));
    unsigned char* ws = P.ws; unsigned char* big = ws + WS_BIG;
    const int tid = ltid(), lane = tid & 63, wave = tid >> 6;
    const int gw = lbid() * NWAVES + wave, ngw = G * NWAVES;
    int type, layer = 0, half = 0;
    if (ph == 0) type = T_PRO;
    else if (ph == N_PHASES - 1) type = T_NORM;
    else {
        const int p = ph - 1;
        layer = (p >= 26) ? 3 : (p >= 16) ? 2 : (p >= 7) ? 1 : 0;
        const int start = (layer == 3) ? 26 : (layer == 2) ? 16 : (layer == 1) ? 7 : 0, len = (layer == 1) ? 9 : (layer == 2) ? 10 : 7;
        const int q = p - start, mix = layer % 3;
        if (q < 2) { half = 0; type = (q == 0) ? T_G1 : T_G2; }
        else if (q >= len - 2) { half = 1; type = (q == len - 2) ? T_G1 : T_G2; }
        else { const int r = q - 2, mlen = len - 4;
            if (r == mlen - 1) type = T_RES;
            else if (mix == 0) type = (r == 0) ? T_PJ : T_SCEW;
            else if (mix == 1) type = (r == 0) ? T_PJ : (r == 1) ? T_HYEW1 : (r == 2) ? T_HYFFT : T_HYEW2;
            else type = (r == 0) ? T_GDPJ : (r == 1) ? T_GDPREP : (r == 2) ? T_GDCHUNK : (r == 3) ? T_GDSCAN : T_GDPOST; }
    }
    const int mix = layer % 3, mj = layer / 3;
    bf16* XN = (bf16*)(ws + WS_XN); bf16* A2 = (bf16*)(ws + WS_A2);
#define SSQ_OF(k) ((float*)(ws + (((k) & 1) ? WS_SSQ1 : WS_SSQ0)))
    PG8_LAS unsigned char* glds = (PG8_LAS unsigned char*)lds;
    switch (type) {
    case T_PRO: prologue(P, lds, G); break;
    case T_G1: {
        pg8::Gemm g{XN, (const bf16*)(ws + WS_WFI) + (size_t)(layer * 2 + half) * FF2 * D, M, FF2, D, D, 128, D, 128}; pg8::StaticOrder S; S.init(M, FF2, G, lbid());
        rs_prefill(S, SSQ_OF(layer * 3 + (half ? 2 : 0)), lds);
        EpiSwiglu E{(bf16*)big, (const LAS float*)((LAS unsigned char*)lds + LDS_RS)};
        pg8::gemm_phase<EpiSwiglu, pg8::StaticOrder, true, true>(glds, g, S, E);
        if (G == 256 && layer < 3) convert_tail(P, lds, layer + 1, half);
    } break;
    case T_G2: {
        pg8::Gemm g{(const bf16*)big, (const bf16*)(ws + WS_WFO) + (size_t)(layer * 2 + half) * D * FF, M, D, FF, 64, (size_t)M * 128, 64, (size_t)D * 128}; pg8::StaticOrder S; S.init(M, D, G, lbid());
        const int nk = half ? (layer + 1) * 3 : layer * 3 + 1;
        EpiResid E{XN, nullptr, 1, SSQ_OF(nk)};
        pg8::gemm_phase<EpiResid, pg8::StaticOrder, true, true>(glds, g, S, E);
    } break;
    case T_NORM: final_rows(XN, P.out, P.in[2], SSQ_OF(12), gw, ngw, lane); break;
    case T_PJ: {
        const bf16* W = (mix == 0) ? (const bf16*)(ws + WS_WSI) + (size_t)mj * 3 * D * D : (const bf16*)(ws + WS_WHI);
        pg8::Gemm g{XN, W, M, 3 * D, D, D, 128, D, 128}; pg8::StaticOrder S; S.init(M, 3 * D, G, lbid());
        rs_prefill(S, SSQ_OF(layer * 3 + 1), lds);
        EpiProj E{(bf16*)big, 3 * D, (mix == 1) ? P.in[9] : nullptr, (const LAS float*)((LAS unsigned char*)lds + LDS_RS)};
        pg8::gemm_phase<EpiProj, pg8::StaticOrder, true, true>(glds, g, S, E);
    } break;
    case T_SCEW: sc_ew((const bf16*)big, P.in[6] + (size_t)mj * 3 * D, A2, G); break;
    case T_RES: {
        const bf16* W = (mix == 0) ? (const bf16*)(ws + WS_WSO) + (size_t)mj * D * D : (mix == 1) ? (const bf16*)(ws + WS_WHO) : (const bf16*)(ws + WS_WGO);
        pg8::Gemm g{A2, W, M, D, D, D, 128, D, 128}; pg8::StaticOrder S; S.init(M, D, G, lbid());
        const int nk = layer * 3 + 2;
        if (mix == 1) vec_prefill(P.in[20], P.in[20], lds);
        const LAS float* gl = (const LAS float*)((LAS unsigned char*)lds + LDS_RS);
        EpiResid E{XN, (mix == 1) ? gl + D : nullptr, 0, SSQ_OF(nk)};
        pg8::gemm_phase<EpiResid, pg8::StaticOrder, true, true>(glds, g, S, E);
    } break;
    case T_HYEW1:
        hy_filter((const bf16*)(ws + WS_H2), (const bf16*)(ws + WS_W3T), (float*)(big + BIG_HT), G);
        hy_ew1((const bf16*)big, P.in[10], P.in[11], (bf16*)(big + BIG_X0), (unsigned*)(big + BIG_ZT), lds, G);
        break;
    case T_HYFFT: hy_fft<true>((const float*)(big + BIG_HT), P.in[18], (unsigned*)(big + BIG_ZT), (const f32x2*)(ws + WS_TW), lds, G); break;
    case T_HYEW2: hy_ew2((const unsigned*)(big + BIG_ZT), (const bf16*)(big + BIG_X0), A2, lds, G); break;
    case T_GDPJ: {
        pg8::Gemm g{XN, (const bf16*)(ws + WS_WGI), M, NGD, D, D, 128, D, 128}; pg8::StaticOrder S; S.init(M, NGD, G, lbid());
        rs_prefill(S, SSQ_OF(layer * 3 + 1), lds);
        EpiGD E{(bf16*)big, (bf16*)(big + BIG_Z), (float*)(big + BIG_AB), (const LAS float*)((LAS unsigned char*)lds + LDS_RS)};
        pg8::gemm_phase<EpiGD, pg8::StaticOrder, true, true>(glds, g, S, E);
    } break;
    case T_GDPREP: gd_prep((const bf16*)big, (const float*)(big + BIG_AB), P.in[22], P.in[23], P.in[24], (bf16*)(big + BIG_QKV), (float*)(big + BIG_G), (float*)(big + BIG_G + MiB), G); break;
    case T_GDCHUNK: gd_chunk((const bf16*)(big + BIG_QKV), (const float*)(big + BIG_G), (const float*)(big + BIG_G + MiB), big, lds, G); break;
    case T_GDSCAN: gd_scan<0>(big, (bf16*)(big + BIG_QKV), lds, G, (unsigned*)(ws + WS_CTL)); break;
    case T_GDPOST: gd_post((const bf16*)(big + BIG_QKV), (const bf16*)(big + BIG_Z), P.in[25], A2, G); break;
    default: break;
    }
    return type;
}

__global__ void __launch_bounds__(NTHR, 2) mega_fwd(Params P) {
    extern __shared__ __attribute__((aligned(16))) unsigned char lds[];
    const int G = gridDim.x;
#if MK_MULTI
    (void)run_phase(P.ph_lo, P, lds, G);
#else
    cg::grid_group grid = cg::this_grid();
    volatile LAS unsigned* misc = (volatile LAS unsigned*)((LAS unsigned char*)lds + LDS_MISC);
    if (threadIdx.x < 4) misc[threadIdx.x] = (threadIdx.x < 2) ? 0u : 0xffffffffu;
    __syncthreads();
    if (blockIdx.x == 0) for (int i = threadIdx.x; i < (int)(CTL_BYTES / 4); i += NTHR) __hip_atomic_store((unsigned*)(P.ws + WS_CTL) + i, 0u, __ATOMIC_RELAXED, __HIP_MEMORY_SCOPE_AGENT);
    grid.sync();
    XcdBarrier bar = xcd_barrier_post((unsigned*)(P.ws + WS_CTL), misc);
    for (int ph = P.ph_lo; ph < P.ph_hi; ++ph) {
        const int ty = run_phase(ph, P, lds, G);
#if DUP_MASK
        if ((DUP_MASK >> ty) & 1) { xcd_barrier(bar); run_phase(ph, P, lds, G); }
#endif
#if 0
#endif
#if DUP_FFT
        if (ty == T_HYFFT) { xcd_barrier(bar); hy_fft<false>((const float*)(P.ws + WS_BIG + BIG_HT), P.in[18], (unsigned*)(P.ws + WS_BIG + BIG_ZT), (const f32x2*)(P.ws + WS_TW), lds, G); }
#endif
#if DUP_SCANVAR
        if (ty == T_GDSCAN) { xcd_barrier(bar); gd_scan<DUP_SCANVAR>(P.ws + WS_BIG, (bf16*)(P.ws + WS_BIG + BIG_QKV), lds, G, (unsigned*)(P.ws + WS_CTL)); }
#endif
#if DUP_BAR
        xcd_barrier(bar);
#endif
        if (ph + 1 < P.ph_hi) xcd_barrier(bar);
    }
#endif
}

extern "C" void kernel_launch(void* const* d_in, const int* in_sizes, int n_in, void* d_out, int out_size, void* d_ws, size_t ws_size, hipStream_t stream) {
    static int grid = 0;
    if (grid == 0) {
        if (n_in != 27 || out_size != M * D || ws_size < WS_END) { fprintf(stderr, "kernel_launch: unexpected shapes (n_in %d out %d ws %zu, need %zu)\n", n_in, out_size, ws_size, (size_t)WS_END); grid = -1; return; }
        int dev = 0, cus = 0, per_cu = 0;
        (void)hipGetDevice(&dev); (void)hipDeviceGetAttribute(&cus, hipDeviceAttributeMultiprocessorCount, dev);
        if (hipFuncSetAttribute((const void*)mega_fwd, hipFuncAttributeMaxDynamicSharedMemorySize, LDS_BYTES) != hipSuccess) { fprintf(stderr, "kernel_launch: hipFuncSetAttribute failed\n"); grid = -1; return; }
        if (hipOccupancyMaxActiveBlocksPerMultiprocessor(&per_cu, (const void*)mega_fwd, NTHR, LDS_BYTES) != hipSuccess || per_cu < 1) { fprintf(stderr, "kernel_launch: occupancy query says %d\n", per_cu); per_cu = 1; }
        (void)hipGetLastError();
        grid = cus > 0 ? cus : 256;
    }
    if (grid < 0) return;
    Params p{};
    for (int i = 0; i < 27; ++i) p.in[i] = (const float*)d_in[i];
    p.out = (float*)d_out; p.ws = (unsigned char*)d_ws;
#if MK_MULTI
    for (int ph = 0; ph < N_PHASES; ++ph) { p.ph_lo = ph; p.ph_hi = ph + 1; hipLaunchKernelGGL(mega_fwd, dim3(grid), dim3(NTHR), LDS_BYTES, stream, p); }
#else
    p.ph_lo = 0; p.ph_hi = N_PHASES;
    void* args[] = {&p};
    hipError_t e = hipLaunchCooperativeKernel((const void*)mega_fwd, dim3(grid), dim3(NTHR), args, LDS_BYTES, stream);
    if (e != hipSuccess) fprintf(stderr, "cooperative launch failed: %s (grid %d)\n", hipGetErrorString(e), grid);
#endif
}
```

```cpp
#include <hip/hip_runtime.h>
#include <hip/hip_cooperative_groups.h>
#include <cstdio>
#include <cstdint>
namespace cg = cooperative_groups;

#ifndef DUP_MASK
#define DUP_MASK 0
#endif
#ifndef DUP_SCANVAR
#define DUP_SCANVAR 0
#endif
#ifndef DUP_G2
#define DUP_G2 0
#endif
#ifndef DUP_FFT
#define DUP_FFT 0
#endif
#ifndef DUP_BAR
#define DUP_BAR 0
#endif
#ifndef MK_MULTI
#define MK_MULTI 0
#endif

__device__ __forceinline__ int ltid() { int t = threadIdx.x; asm volatile("" : "+v"(t)); return t; }
__device__ __forceinline__ int lbid() { int b = blockIdx.x; asm volatile("" : "+s"(b)); return b; }
namespace pg8 {
#define PG8_LAS __attribute__((address_space(3)))
typedef unsigned short bf16_t;
typedef short bf16x8 __attribute__((ext_vector_type(8)));
typedef float f32x4 __attribute__((ext_vector_type(4)));
typedef unsigned u32x4 __attribute__((ext_vector_type(4)));
constexpr int BM = 256, BK = 64, HALF = 128, HTB = HALF * BK * 2, STAGE_BYTES = 8 * HTB, NXCD = 8, WGM = 8;

__host__ __device__ __forceinline__ int lds_byte(int r, int c) { const int st = (r >> 4) * 2 + (c >> 5), rr = r & 15, cc = c & 31, ob = rr * 64 + cc * 2; return st * 1024 + (ob ^ (((ob >> 9) & 1) << 5)); }
__host__ __device__ __forceinline__ void stage_rc(int b, int& R, int& C) { const int st = b / 1024, sb = b % 1024, swz = sb ^ (((sb >> 9) & 1) << 5); R = (st >> 1) * 16 + swz / 64; C = (st & 1) * 32 + (swz % 64) / 2; }
__host__ __device__ __forceinline__ int perm32(int rho) { const int n = rho >> 4, i = rho & 15; return 8 * (i >> 2) + 4 * n + (i & 3); }

struct Unit { int pm, pn; };
struct Gemm { const bf16_t* A; const bf16_t* Bt; int M, N, K; int lda; size_t kstepA; int ldb; size_t kstepB; };

struct StaticOrder {
    int nM, nN, nwg, G, c;
    __host__ __device__ void init(int M, int N, int G_, int c_) { nM = M / BM; nN = N / BM; nwg = nM * nN; G = G_; c = c_; }
    __host__ __device__ bool next(int i, Unit& u) const {
        const long L = (long)i * G + c; if (L >= nwg) return false;
        int wgid = (int)L; { const int q = nwg / NXCD, r = nwg % NXCD, xcd = wgid % NXCD, off = wgid / NXCD; wgid = (xcd < r ? xcd * (q + 1) : r * (q + 1) + (xcd - r) * q) + off; }
        const int nig = WGM * nN, gid = wgid / nig, fm = gid * WGM, gsz = (nM - fm) < WGM ? (nM - fm) : WGM;
        u.pm = fm + ((wgid % nig) % gsz); u.pn = (wgid % nig) / gsz; return true;
    }
    __device__ __forceinline__ void a_ready(const Unit&) const {}
    __device__ __forceinline__ void done(const Unit&) const {}
};

typedef float f32x2_t __attribute__((ext_vector_type(2))); typedef __bf16 bf16x2_t __attribute__((ext_vector_type(2)));
__device__ __forceinline__ unsigned cvt_pk_bf16(float lo, float hi) { f32x2_t v = {lo, hi}; bf16x2_t b = __builtin_convertvector(v, bf16x2_t); return __builtin_bit_cast(unsigned, b); }

template <class Epi, class Sched, bool ALIGN_EPI = false, bool SP2 = false>
__device__ __forceinline__ void gemm_phase(PG8_LAS unsigned char* lds, const Gemm g, const Sched& S, const Epi& E) {
    const int tid = ltid(), wid = __builtin_amdgcn_readfirstlane(tid >> 6), lane = tid & 63, wr = wid >> 2, wc = wid & 3, fr = lane & 15, fq = lane >> 4;
    const int K = g.K, nt = K / BK;
    unsigned voffA[2], voffB[2];
#pragma unroll
    for (int i = 0; i < 2; ++i) { int R, C; stage_rc(tid * 16 + i * 8192, R, C); const int Rb = Epi::PERM ? ((R & ~31) + perm32(R & 31)) : R;
        voffA[i] = (unsigned)(R * g.lda + C) * 2u; voffB[i] = (unsigned)(Rb * g.ldb + C) * 2u; }
    const size_t kstep = g.kstepB;
    const size_t hstep = (size_t)HALF * g.ldb * 2;
    const size_t tstep = 2 * hstep;
    const size_t kstepA = g.kstepA, hstepA = (size_t)HALF * g.lda * 2, tstepA = 2 * hstepA;
    const unsigned ldsw = (unsigned)wid * 1024u;
    const int aoff = lds_byte(wr * 64 + fr, fq * 8), boff = lds_byte(wc * 32 + fr, fq * 8);
#define PG8_SA(b, h) (((b) * 2 + (h)) * HTB)
#define PG8_SB(b, h) ((4 + (b) * 2 + (h)) * HTB)
#define PG8_STAGE(bufoff, gbase, voff) do { _Pragma("unroll") for (int _i = 0; _i < 2; ++_i) \
        __builtin_amdgcn_global_load_lds((const unsigned*)((const char*)(gbase) + (voff)[_i]), (PG8_LAS unsigned*)(lds + (bufoff) + ldsw + _i * 8192), 16, 0, 0); } while (0)
#define PG8_LDA(dst, b, h) do { _Pragma("unroll") for (int m = 0; m < 4; ++m) _Pragma("unroll") for (int k = 0; k < 2; ++k) dst[m][k] = *(const PG8_LAS bf16x8*)(lds + PG8_SA(b, h) + aoff + m * 2048 + k * 1024); } while (0)
#define PG8_LDB(dst, b, h) do { _Pragma("unroll") for (int n = 0; n < 2; ++n) _Pragma("unroll") for (int k = 0; k < 2; ++k) dst[n][k] = *(const PG8_LAS bf16x8*)(lds + PG8_SB(b, h) + boff + n * 2048 + k * 1024); } while (0)
#define PG8_MMA(ai, bj, At, Bt) do { __builtin_amdgcn_s_setprio(1); _Pragma("unroll") for (int m = 0; m < 4; ++m) _Pragma("unroll") for (int n = 0; n < 2; ++n) _Pragma("unroll") for (int k = 0; k < 2; ++k) \
        acc[ai][bj][m][n] = __builtin_amdgcn_mfma_f32_16x16x32_bf16(Bt[n][k], At[m][k], acc[ai][bj][m][n], 0, 0, 0); __builtin_amdgcn_s_setprio(0); } while (0)
#define PG8_WAIT_V(n) asm volatile("s_waitcnt vmcnt(" #n ")" ::: "memory")
#define PG8_WAIT_L(n) asm volatile("s_waitcnt lgkmcnt(" #n ")" ::: "memory")
#define PG8_BAR __builtin_amdgcn_s_barrier()
#define PG8_SCHED __builtin_amdgcn_sched_barrier(0)
    Unit cur, nxt; int ui = 0;
    if (!S.next(0, cur)) return;
    f32x4 acc[2][2][4][2];
#pragma unroll
    for (int a = 0; a < 2; ++a)
#pragma unroll
        for (int b = 0; b < 2; ++b)
#pragma unroll
            for (int m = 0; m < 4; ++m)
#pragma unroll
                for (int n = 0; n < 2; ++n) acc[a][b][m][n] = (f32x4){0.f, 0.f, 0.f, 0.f};
    bf16x8 At[4][2], B0[2][2], B1[2][2];
    const char* cA = (const char*)g.A + (size_t)cur.pm * tstepA; const char* cB = (const char*)g.Bt + (size_t)cur.pn * tstep;
    if constexpr (Epi::HAS_INIT) E.init(acc, cur, wr, wc, fr, fq);
    S.a_ready(cur);
    if constexpr (SP2) {
        PG8_STAGE(PG8_SB(0, 0), cB, voffB); PG8_STAGE(PG8_SB(0, 1), cB + hstep, voffB); PG8_STAGE(PG8_SA(0, 0), cA, voffA); PG8_STAGE(PG8_SA(0, 1), cA + hstepA, voffA);
        if (wr == 1) PG8_BAR;
        PG8_WAIT_V(2); PG8_BAR;
        PG8_STAGE(PG8_SB(1, 0), cB + kstep, voffB); PG8_STAGE(PG8_SA(1, 0), cA + kstepA, voffA); PG8_STAGE(PG8_SB(1, 1), cB + hstep + kstep, voffB);
        PG8_WAIT_V(6); PG8_BAR;
    } else {
        PG8_STAGE(PG8_SB(0, 0), cB, voffB); PG8_STAGE(PG8_SA(0, 0), cA, voffA); PG8_STAGE(PG8_SB(0, 1), cB + hstep, voffB); PG8_STAGE(PG8_SA(0, 1), cA + hstepA, voffA);
        if (wr == 1) PG8_BAR;
        PG8_WAIT_V(4); PG8_BAR;
        PG8_STAGE(PG8_SB(1, 0), cB + kstep, voffB); PG8_STAGE(PG8_SA(1, 0), cA + kstepA, voffA); PG8_STAGE(PG8_SB(1, 1), cB + hstep + kstep, voffB);
        PG8_WAIT_V(6); PG8_BAR;
    }
    for (;;) {
        const bool has_next = S.next(ui + 1, nxt);
        const char* nA = has_next ? (const char*)g.A + (size_t)nxt.pm * tstepA : cA; const char* nB = has_next ? (const char*)g.Bt + (size_t)nxt.pn * tstep : cB;
        for (int t = 0; t < nt; t += 2) {
            const bool last = (t == nt - 2);
            const char* a1 = cA + (size_t)(t + 1) * kstepA;
            const char* a2 = last ? nA : cA + (size_t)(t + 2) * kstepA; const char* b2 = last ? nB : cB + (size_t)(t + 2) * kstep;
            const char* a3 = a2 + kstepA; const char* b3 = b2 + kstep;
            if (last && has_next) S.a_ready(nxt);
            if constexpr (SP2) {
            PG8_LDB(B0, 0, 0); PG8_LDB(B1, 0, 1); PG8_SCHED; PG8_LDA(At, 0, 0); PG8_STAGE(PG8_SA(1, 1), a1 + hstepA, voffA);
            PG8_WAIT_V(8); PG8_WAIT_L(0); PG8_BAR; PG8_MMA(0, 0, At, B0); PG8_MMA(0, 1, At, B1); PG8_BAR; PG8_SCHED;
            PG8_LDA(At, 0, 1); PG8_STAGE(PG8_SB(0, 0), b2, voffB); PG8_STAGE(PG8_SB(0, 1), b2 + hstep, voffB); PG8_STAGE(PG8_SA(0, 0), a2, voffA);
            PG8_WAIT_V(8); PG8_WAIT_L(0); PG8_BAR; PG8_MMA(1, 0, At, B0); PG8_MMA(1, 1, At, B1); PG8_BAR; PG8_SCHED;
            PG8_LDB(B0, 1, 0); PG8_LDB(B1, 1, 1); PG8_SCHED; PG8_LDA(At, 1, 0); PG8_STAGE(PG8_SA(0, 1), a2 + hstepA, voffA);
            PG8_WAIT_V(8); PG8_WAIT_L(0); PG8_BAR; PG8_MMA(0, 0, At, B0); PG8_MMA(0, 1, At, B1); PG8_BAR; PG8_SCHED;
            PG8_LDA(At, 1, 1); PG8_STAGE(PG8_SB(1, 0), b3, voffB); PG8_STAGE(PG8_SB(1, 1), b3 + hstep, voffB); PG8_STAGE(PG8_SA(1, 0), a3, voffA);
            PG8_WAIT_V(8); PG8_WAIT_L(0); PG8_BAR; PG8_MMA(1, 0, At, B0); PG8_MMA(1, 1, At, B1); PG8_BAR; PG8_SCHED;
            } else {
            PG8_LDB(B0, 0, 0); PG8_SCHED; PG8_LDA(At, 0, 0); PG8_STAGE(PG8_SA(1, 1), a1 + hstepA, voffA);
            PG8_WAIT_L(8); PG8_BAR; PG8_WAIT_L(0); PG8_MMA(0, 0, At, B0); PG8_BAR; PG8_SCHED;
            PG8_LDB(B1, 0, 1); PG8_STAGE(PG8_SB(0, 0), b2, voffB);
            PG8_BAR; PG8_WAIT_L(0); PG8_MMA(0, 1, At, B1); PG8_BAR;
            PG8_LDA(At, 0, 1); PG8_STAGE(PG8_SA(0, 0), a2, voffA);
            PG8_BAR; PG8_WAIT_L(0); PG8_MMA(1, 0, At, B0); PG8_BAR; PG8_SCHED;
            PG8_STAGE(PG8_SB(0, 1), b2 + hstep, voffB);
            PG8_WAIT_V(6); PG8_BAR; PG8_MMA(1, 1, At, B1); PG8_BAR;
            PG8_LDB(B0, 1, 0); PG8_SCHED; PG8_LDA(At, 1, 0); PG8_STAGE(PG8_SA(0, 1), a2 + hstepA, voffA);
            PG8_WAIT_L(8); PG8_BAR; PG8_WAIT_L(0); PG8_MMA(0, 0, At, B0); PG8_BAR; PG8_SCHED;
            PG8_LDB(B1, 1, 1); PG8_STAGE(PG8_SB(1, 0), b3, voffB);
            PG8_BAR; PG8_WAIT_L(0); PG8_MMA(0, 1, At, B1); PG8_BAR;
            PG8_LDA(At, 1, 1); PG8_STAGE(PG8_SA(1, 0), a3, voffA);
            PG8_BAR; PG8_WAIT_L(0); PG8_MMA(1, 0, At, B0); PG8_BAR; PG8_SCHED;
            PG8_STAGE(PG8_SB(1, 1), b3 + hstep, voffB);
            PG8_WAIT_V(6); PG8_BAR; PG8_MMA(1, 1, At, B1); PG8_BAR;
            }
        }
        if constexpr (ALIGN_EPI) { if (wr == 0) PG8_BAR; }
        E(acc, cur, wr, wc, fr, fq, ui);
        if (!has_next) break;
#pragma unroll
        for (int a = 0; a < 2; ++a)
#pragma unroll
            for (int b = 0; b < 2; ++b)
#pragma unroll
                for (int m = 0; m < 4; ++m)
#pragma unroll
                    for (int n = 0; n < 2; ++n) acc[a][b][m][n] = (f32x4){0.f, 0.f, 0.f, 0.f};
        cur = nxt; cA = nA; cB = nB; ++ui;
        if constexpr (Epi::HAS_INIT) E.init(acc, cur, wr, wc, fr, fq);
        if constexpr (ALIGN_EPI) { if (wr == 1) PG8_BAR; }
    }
    PG8_WAIT_V(0);
    if constexpr (!ALIGN_EPI) { if (wr == 0) PG8_BAR; }
    PG8_BAR;
#undef PG8_SA
#undef PG8_SB
#undef PG8_STAGE
#undef PG8_LDA
#undef PG8_LDB
#undef PG8_MMA
#undef PG8_WAIT_V
#undef PG8_WAIT_L
#undef PG8_BAR
#undef PG8_SCHED
}
}

constexpr int D = 1024, SEQ = 8192, NB = 2, M = NB * SEQ, FF = 2816, FF2 = 5632, DEPTH = 4;
constexpr int GH = 8, GDK = 128, GC = 64, GNCH = SEQ / GC;
constexpr int NGD = 4352;
constexpr float NORM_EPS = 1e-6f;
constexpr int NTHR = 512, NWAVES = 8;
constexpr int FFTN = 16384;

typedef unsigned short bf16;
typedef short bf16x8 __attribute__((ext_vector_type(8)));
typedef float f32x4 __attribute__((ext_vector_type(4)));
typedef float f32x2 __attribute__((ext_vector_type(2)));
typedef unsigned u32x4 __attribute__((ext_vector_type(4)));
typedef unsigned u32x2 __attribute__((ext_vector_type(2)));
#define LAS __attribute__((address_space(3)))

constexpr size_t MiB = 1u << 20;
constexpr size_t WS_TW = 0;
constexpr size_t WS_W3T = 65536;
constexpr size_t WS_CTL = 512 * 1024, CTL_BYTES = 16384;
constexpr size_t WS_H2 = 1 * MiB;
constexpr size_t WS_SSQ0 = 3 * MiB, WS_SSQ1 = 171 * MiB;
constexpr size_t WS_WFI = 4 * MiB;
constexpr size_t WS_WFO = 92 * MiB;
constexpr size_t WS_WSI = 136 * MiB;
constexpr size_t WS_WSO = 148 * MiB;
constexpr size_t WS_WHI = 152 * MiB;
constexpr size_t WS_WHO = 158 * MiB;
constexpr size_t WS_WGI = 160 * MiB;
constexpr size_t WS_WGO = 169 * MiB;
constexpr size_t WS_XN = 172 * MiB;
constexpr size_t WS_A2 = 204 * MiB;
constexpr size_t WS_BIG = 236 * MiB;
constexpr size_t BIG_X0 = 96 * MiB;
constexpr size_t BIG_ZT = 128 * MiB;
constexpr size_t BIG_HT = 192 * MiB;
constexpr size_t CH_W = 0, CH_QD = 64 * MiB, CH_KDT = 128 * MiB, CH_UT = 192 * MiB, CH_AT = 256 * MiB;
constexpr size_t BIG_Z = 288 * MiB;
constexpr size_t BIG_AB = 320 * MiB;
constexpr size_t BIG_QKV = 322 * MiB;
constexpr size_t BIG_G = 418 * MiB;
constexpr size_t BIG_GT = 420 * MiB;
constexpr size_t WS_END = WS_BIG + 421 * MiB;

constexpr int LDS_BYTES = 143360;
constexpr int LDS_MISC = LDS_BYTES - 64;

__device__ __forceinline__ float bf2f(unsigned v) { return __uint_as_float(v << 16); }
__device__ __forceinline__ float bflo(unsigned v) { return __uint_as_float(v << 16); }
__device__ __forceinline__ float bfhi(unsigned v) { return __uint_as_float(v & 0xffff0000u); }
__device__ __forceinline__ unsigned pk2(float lo, float hi) { return pg8::cvt_pk_bf16(lo, hi); }
__device__ __forceinline__ float wave_sum(float v) {
#pragma unroll
    for (int o = 1; o < 64; o <<= 1) v += __shfl_xor(v, o);
    return v;
}
__device__ __forceinline__ float silu_f(float x) { return x * __builtin_amdgcn_rcpf(1.f + __expf(-x)); }
__device__ __forceinline__ float sigmoid_f(float x) { return __builtin_amdgcn_rcpf(1.f + __expf(-x)); }


#define XB_TMO      128
#define XB_XCNT(j)  (256  + 64 * (j))
#define XB_XSUB(j)  (1280 + 64 * (j))
#define XB_XGEN(j)  (2304 + 64 * (j))
#define XB_TOP      3328
#define XB_TOPGEN   3392
#define XCD_BAR_WORDS 3456
#define XB_SPIN_CAP (1u << 22)
__device__ __forceinline__ unsigned xb_ld(unsigned* p)              { return __hip_atomic_load(p, __ATOMIC_RELAXED, __HIP_MEMORY_SCOPE_AGENT); }
__device__ __forceinline__ unsigned xb_add(unsigned* p, unsigned v) { return __hip_atomic_fetch_add(p, v, __ATOMIC_RELAXED, __HIP_MEMORY_SCOPE_AGENT); }
__device__ __forceinline__ unsigned xb_xcc_id() { return (unsigned)__builtin_amdgcn_s_getreg((3 << 11) | 20) & 0xFu; }
#define XB_SPIN(cond, bar) do { unsigned _sp = 0; while (cond) { __builtin_amdgcn_s_sleep(1); \
    if ((++_sp & 255u) == 0u) { if (xb_ld(&(bar)[XB_TMO])) break; if (_sp > XB_SPIN_CAP) { atomicAdd(&(bar)[XB_TMO], 1u); break; } } } } while (0)
struct XcdBarrier { unsigned* bar; unsigned x; volatile LAS unsigned* st; };
__device__ __forceinline__ XcdBarrier xcd_barrier_post(unsigned* bar, volatile LAS unsigned* st) {
    XcdBarrier b; b.bar = bar; b.x = xb_xcc_id(); b.st = st;
    if (threadIdx.x == 0) { const unsigned li = xb_add(&bar[XB_XCNT(b.x)], 1u); st[2] = li; st[3] = b.x; }
    return b;
}
__device__ __forceinline__ void xcd_barrier_complete(unsigned* bar, unsigned x, unsigned& nloc, unsigned& nx) {
    const unsigned G = gridDim.x * gridDim.y * gridDim.z;
    unsigned sum, cnt, mine, sp = 0u;
    for (;;) {
        sum = 0u; cnt = 0u; mine = 0u;
#pragma unroll
        for (unsigned j = 0; j < 16; ++j) { const unsigned c = xb_ld(&bar[XB_XCNT(j)]); sum += c; cnt += (c > 0u) ? 1u : 0u; mine = (j == x) ? c : mine; }
        if (sum == G) break;
        __builtin_amdgcn_s_sleep(1);
        if ((++sp & 255u) == 0u) { if (xb_ld(&bar[XB_TMO])) break; if (sp > XB_SPIN_CAP) { atomicAdd(&bar[XB_TMO], 1u); break; } }
    }
    nloc = mine > 0u ? mine : 1u; nx = cnt > 0u ? cnt : 1u;
}
__device__ __forceinline__ void xcd_barrier(const XcdBarrier& b) {
    asm volatile("s_waitcnt vmcnt(0)" ::: "memory");
    __syncthreads();
    if (threadIdx.x == 0) {
        unsigned* bar = b.bar;
        __builtin_amdgcn_s_waitcnt(0);
        unsigned nloc = b.st[0], nx = b.st[1];
        if (nloc == 0u) { xcd_barrier_complete(bar, b.x, nloc, nx); b.st[0] = nloc; b.st[1] = nx; }
        const unsigned old = xb_add(&bar[XB_XSUB(b.x)], 1u);
        const unsigned gen = old / nloc;
        if (old + 1u == (gen + 1u) * nloc) {
            __builtin_amdgcn_fence(__ATOMIC_RELEASE, "agent");
            asm volatile("s_waitcnt vmcnt(0)" ::: "memory");
            const unsigned og = xb_add(&bar[XB_TOP], 1u);
            const unsigned tg = og / nx;
            if (og + 1u == (tg + 1u) * nx) xb_add(&bar[XB_TOPGEN], 1u);
            else XB_SPIN(xb_ld(&bar[XB_TOPGEN]) == tg, bar);
            __builtin_amdgcn_fence(__ATOMIC_ACQUIRE, "agent");
            xb_add(&bar[XB_XGEN(b.x)], 1u);
            asm volatile("s_waitcnt vmcnt(0)" ::: "memory");
        } else {
            XB_SPIN(xb_ld(&bar[XB_XGEN(b.x)]) == gen, bar);
            __builtin_amdgcn_fence(__ATOMIC_ACQUIRE, "agent");
            asm volatile("s_waitcnt vmcnt(0)" ::: "memory");
        }
    }
    __syncthreads();
}

__device__ __forceinline__ float row_rstd(const float* ssq, int row) {
    const f32x4* p = (const f32x4*)(ssq + (size_t)row * 16); const f32x4 a = p[0], b = p[1], c = p[2], d = p[3];
    const f32x4 t = (a + b) + (c + d);
    return rsqrtf(((t[0] + t[1]) + (t[2] + t[3])) * (1.0f / D) + NORM_EPS);
}

struct Params { const float* in[27]; float* out; unsigned char* ws; int ph_lo, ph_hi; };

struct EpiSwiglu {
    static constexpr bool PERM = true, HAS_INIT = false;
    bf16* Hout; const LAS float* rsb;
    __device__ __forceinline__ void operator()(const f32x4 (&acc)[2][2][4][2], const pg8::Unit& u, int wr, int wc, int fr, int fq, int ui) const {
        const int row0 = u.pm * 256 + wr * 64 + fr, col0 = u.pn * 128 + wc * 32 + 8 * fq;
#pragma unroll
        for (int ai = 0; ai < 2; ++ai)
#pragma unroll
            for (int m = 0; m < 4; ++m) {
                const int row = row0 + ai * 128 + m * 16; const float rs = rsb[ui * 256 + (row & 255)];
                bf16* rowp = Hout + ((size_t)(col0 >> 6) * M + row) * 64 + (col0 & 63);
                const f32x4 g0 = acc[ai][0][m][0] * rs, g1 = acc[ai][0][m][1] * rs, u0 = acc[ai][1][m][0] * rs, u1 = acc[ai][1][m][1] * rs;
                u32x4 w;
                w.x = pk2(silu_f(g0[0]) * u0[0], silu_f(g0[1]) * u0[1]); w.y = pk2(silu_f(g0[2]) * u0[2], silu_f(g0[3]) * u0[3]);
                w.z = pk2(silu_f(g1[0]) * u1[0], silu_f(g1[1]) * u1[1]); w.w = pk2(silu_f(g1[2]) * u1[2], silu_f(g1[3]) * u1[3]);
                *(u32x4*)rowp = w;
            }
    }
};
struct EpiResid {
    static constexpr bool PERM = true, HAS_INIT = true;
    bf16* XB; const LAS float* bias; int halfstep; float* ssq;
    __device__ __forceinline__ void init(f32x4 (&acc)[2][2][4][2], const pg8::Unit& u, int wr, int wc, int fr, int fq) const {
        const int row0 = u.pm * 256 + wr * 64 + fr, col0 = u.pn * 256 + wc * 32 + 8 * fq;
        const float ia = halfstep ? 2.0f : 1.0f;
#pragma unroll
        for (int ai = 0; ai < 2; ++ai)
#pragma unroll
            for (int m = 0; m < 4; ++m) { const size_t off = (size_t)(row0 + ai * 128 + m * 16) * D + col0;
#pragma unroll
                for (int bj = 0; bj < 2; ++bj) { const u32x4 x = *(const u32x4*)(XB + off + bj * 128);
                    acc[ai][bj][m][0] = (f32x4){bflo(x.x), bfhi(x.x), bflo(x.y), bfhi(x.y)} * ia; acc[ai][bj][m][1] = (f32x4){bflo(x.z), bfhi(x.z), bflo(x.w), bfhi(x.w)} * ia; } }
    }
    __device__ __forceinline__ void operator()(const f32x4 (&acc)[2][2][4][2], const pg8::Unit& u, int wr, int wc, int fr, int fq, int ui) const {
        const int row0 = u.pm * 256 + wr * 64 + fr, col0 = u.pn * 256 + wc * 32 + 8 * fq;
        const float alpha = halfstep ? 0.5f : 1.0f;
        f32x4 bv[2][2];
#pragma unroll
        for (int bj = 0; bj < 2; ++bj)
#pragma unroll
            for (int n = 0; n < 2; ++n) bv[bj][n] = bias ? *(const LAS f32x4*)(bias + col0 + bj * 128 + 4 * n) : (f32x4){0.f, 0.f, 0.f, 0.f};
#pragma unroll
        for (int ai = 0; ai < 2; ++ai)
#pragma unroll
            for (int m = 0; m < 4; ++m) { const int row = row0 + ai * 128 + m * 16; const size_t off = (size_t)row * D + col0;
                float sq = 0.f;
#pragma unroll
                for (int bj = 0; bj < 2; ++bj) {
                    const f32x4 v0 = (acc[ai][bj][m][0] + bv[bj][0]) * alpha, v1 = (acc[ai][bj][m][1] + bv[bj][1]) * alpha;
                    sq += ((v0[0] * v0[0] + v0[1] * v0[1]) + (v0[2] * v0[2] + v0[3] * v0[3])) + ((v1[0] * v1[0] + v1[1] * v1[1]) + (v1[2] * v1[2] + v1[3] * v1[3]));
                    u32x4 w; w.x = pk2(v0[0], v0[1]); w.y = pk2(v0[2], v0[3]); w.z = pk2(v1[0], v1[1]); w.w = pk2(v1[2], v1[3]);
                    *(u32x4*)(XB + off + bj * 128) = w; }
                sq += __shfl_xor(sq, 16); sq += __shfl_xor(sq, 32);
                if (fq == 0) ssq[(size_t)row * 16 + u.pn * 4 + wc] = sq; }
    }
};
struct EpiProj {
    static constexpr bool PERM = true, HAS_INIT = false;
    bf16* O; int ldc; const float* bias; const LAS float* rsb;
    __device__ __forceinline__ void operator()(const f32x4 (&acc)[2][2][4][2], const pg8::Unit& u, int wr, int wc, int fr, int fq, int ui) const {
        const int row0 = u.pm * 256 + wr * 64 + fr, col0 = u.pn * 256 + wc * 32 + 8 * fq;
        f32x4 bv[2][2];
#pragma unroll
        for (int bj = 0; bj < 2; ++bj)
#pragma unroll
            for (int n = 0; n < 2; ++n) bv[bj][n] = bias ? *(const f32x4*)(bias + col0 + bj * 128 + 4 * n) : (f32x4){0.f, 0.f, 0.f, 0.f};
#pragma unroll
        for (int ai = 0; ai < 2; ++ai)
#pragma unroll
            for (int m = 0; m < 4; ++m) { const int row = row0 + ai * 128 + m * 16; const float rs = rsb[ui * 256 + (row & 255)]; bf16* rowp = O + (size_t)row * ldc + col0;
#pragma unroll
                for (int bj = 0; bj < 2; ++bj) { const f32x4 v0 = acc[ai][bj][m][0] * rs + bv[bj][0], v1 = acc[ai][bj][m][1] * rs + bv[bj][1];
                    u32x4 w; w.x = pk2(v0[0], v0[1]); w.y = pk2(v0[2], v0[3]); w.z = pk2(v1[0], v1[1]); w.w = pk2(v1[2], v1[3]);
                    *(u32x4*)(rowp + bj * 128) = w; } }
    }
};
struct EpiGD {
    static constexpr bool PERM = true, HAS_INIT = false;
    bf16* PJ3; bf16* Z; float* AB; const LAS float* rsb;
    __device__ __forceinline__ void operator()(const f32x4 (&acc)[2][2][4][2], const pg8::Unit& u, int wr, int wc, int fr, int fq, int ui) const {
        const int row0 = u.pm * 256 + wr * 64 + fr;
        if (u.pn < 16) {
            bf16* O; int ldc, col0;
            if (u.pn < 12) { O = PJ3; ldc = 3072; col0 = u.pn * 256 + wc * 32 + 8 * fq; } else { O = Z; ldc = 1024; col0 = (u.pn - 12) * 256 + wc * 32 + 8 * fq; }
#pragma unroll
            for (int ai = 0; ai < 2; ++ai)
#pragma unroll
                for (int m = 0; m < 4; ++m) { const int row = row0 + ai * 128 + m * 16; const float rs = rsb[ui * 256 + (row & 255)]; bf16* rowp = O + (size_t)row * ldc + col0;
#pragma unroll
                    for (int bj = 0; bj < 2; ++bj) { const f32x4 v0 = acc[ai][bj][m][0] * rs, v1 = acc[ai][bj][m][1] * rs;
                        u32x4 w; w.x = pk2(v0[0], v0[1]); w.y = pk2(v0[2], v0[3]); w.z = pk2(v1[0], v1[1]); w.w = pk2(v1[2], v1[3]);
                        *(u32x4*)(rowp + bj * 128) = w; } }
        } else if (wc == 0) {
#pragma unroll
            for (int ai = 0; ai < 2; ++ai)
#pragma unroll
                for (int m = 0; m < 4; ++m) { const int row = row0 + ai * 128 + m * 16; const float rs = rsb[ui * 256 + (row & 255)]; float* rowp = AB + (size_t)row * 32 + 8 * fq;
                    *(f32x4*)rowp = acc[ai][0][m][0] * rs; *(f32x4*)(rowp + 4) = acc[ai][0][m][1] * rs; }
        }
    }
};

__device__ __forceinline__ void transpose_item(const float* W, int K, int N, bf16* WT, int k0, int n0, int drow0, LAS float* scr, int lane, const float* gain, bool kblk) {
    f32x4 v[8];
#pragma unroll
    for (int i = 0; i < 8; ++i) { const int k = k0 + 8 * i + (lane >> 3); v[i] = *(const f32x4*)(W + (size_t)k * N + n0 + 4 * (lane & 7));
        if (gain) v[i] = v[i] * gain[k]; }
#pragma unroll
    for (int i = 0; i < 8; ++i) { LAS float* d = scr + (8 * i + (lane >> 3)) * 33 + 4 * (lane & 7); d[0] = v[i].x; d[1] = v[i].y; d[2] = v[i].z; d[3] = v[i].w; }
    asm volatile("s_waitcnt lgkmcnt(0)" ::: "memory");
    const int c = lane & 7;
#pragma unroll
    for (int j = 0; j < 4; ++j) { const int n = (lane >> 3) + 8 * j; const LAS float* s = scr + (8 * c) * 33 + n;
        u32x4 o; o.x = pk2(s[0 * 33], s[1 * 33]); o.y = pk2(s[2 * 33], s[3 * 33]); o.z = pk2(s[4 * 33], s[5 * 33]); o.w = pk2(s[6 * 33], s[7 * 33]);
        *(u32x4*)(WT + (kblk ? ((size_t)(k0 >> 6) * N + drow0 + n) * 64 + 8 * c : (size_t)(drow0 + n) * K + k0 + 8 * c)) = o; }
    asm volatile("s_waitcnt lgkmcnt(0)" ::: "memory");
}
__device__ __forceinline__ void transpose_job(const float* W, int K, int N, bf16* WT, int item, bool swz, LAS float* scr, int lane, const float* gain = nullptr, bool kblk = false) {
    const int nblk = N / 32, kb = item / nblk, nb = item % nblk, k0 = 64 * kb, n0 = 32 * nb;
    int drow0 = n0;
    if (swz) { const int c = n0 < FF ? n0 : n0 - FF; drow0 = 256 * (c / 128) + (n0 < FF ? 0 : 128) + (c % 128); }
    transpose_item(W, K, N, WT, k0, n0, drow0, scr, lane, gain, kblk);
}

__device__ __forceinline__ void xg_rows(const float* x, const float* g, bf16* xg, float* ssq, int gw, int ngw, int lane) {
    for (int m = gw; m < M; m += ngw) {
        const f32x4* xr = (const f32x4*)(x + (size_t)m * D) + lane;
        f32x4 v[4]; float s = 0.f;
#pragma unroll
        for (int j = 0; j < 4; ++j) { v[j] = xr[64 * j]; s += (v[j].x * v[j].x + v[j].y * v[j].y) + (v[j].z * v[j].z + v[j].w * v[j].w); }
        s = wave_sum(s);
        if (lane < 16) ssq[(size_t)m * 16 + lane] = (lane == 0) ? s : 0.f;
        u32x2* o = (u32x2*)(xg + (size_t)m * D) + lane;
#pragma unroll
        for (int j = 0; j < 4; ++j) { const f32x4 y = v[j]; u32x2 w; w.x = pk2(y.x, y.y); w.y = pk2(y.z, y.w); o[64 * j] = w; }
    }
}
__device__ __forceinline__ void final_rows(const bf16* xb, float* out, const float* g, const float* ssq, int gw, int ngw, int lane) {
    for (int m = gw; m < M; m += ngw) {
        const float rs = row_rstd(ssq, m);
        const u32x2* xr = (const u32x2*)(xb + (size_t)m * D) + lane; f32x4* orow = (f32x4*)(out + (size_t)m * D) + lane;
        u32x2 v[4];
#pragma unroll
        for (int j = 0; j < 4; ++j) v[j] = xr[64 * j];
#pragma unroll
        for (int j = 0; j < 4; ++j) { const f32x4 gg = *((const f32x4*)g + lane + 64 * j); orow[64 * j] = (f32x4){bflo(v[j].x), bfhi(v[j].x), bflo(v[j].y), bfhi(v[j].y)} * rs * gg; }
    }
}

constexpr int I_FI = (D / 64) * (FF2 / 32), I_FO = (FF / 64) * (D / 32), I_SI = (D / 64) * (3 * D / 32), I_DD = (D / 64) * (D / 32), I_GI = (D / 64) * (4128 / 32);
constexpr int T0 = 8 * I_FI, T1 = T0 + 8 * I_FO, T2 = T1 + 2 * I_SI, T3 = T2 + 2 * I_DD, T4 = T3 + I_SI, T5 = T4 + I_DD, T6 = T5 + I_GI, T7 = T6 + I_DD;
__device__ __forceinline__ void convert_item(const Params& P, int it, LAS float* scr, int lane) {
    unsigned char* ws = P.ws;
    if (it < T0) { const int mi = it / I_FI, r = it % I_FI; transpose_job(P.in[3] + (size_t)mi * D * FF2, D, FF2, (bf16*)(ws + WS_WFI) + (size_t)mi * FF2 * D, r, true, scr, lane, P.in[1] + (size_t)(3 * (mi >> 1) + 2 * (mi & 1)) * D); }
    else if (it < T1) { const int q = it - T0, mi = q / I_FO, r = q % I_FO; transpose_job(P.in[4] + (size_t)mi * FF * D, FF, D, (bf16*)(ws + WS_WFO) + (size_t)mi * D * FF, r, false, scr, lane, nullptr, true); }
    else if (it < T2) { const int q = it - T1, mi = q / I_SI, r = q % I_SI; transpose_job(P.in[5] + (size_t)mi * D * 3 * D, D, 3 * D, (bf16*)(ws + WS_WSI) + (size_t)mi * 3 * D * D, r, false, scr, lane, P.in[1] + (size_t)(9 * mi + 1) * D); }
    else if (it < T3) { const int q = it - T2, mi = q / I_DD, r = q % I_DD; transpose_job(P.in[7] + (size_t)mi * D * D, D, D, (bf16*)(ws + WS_WSO) + (size_t)mi * D * D, r, false, scr, lane); }
    else if (it < T4) { transpose_job(P.in[8], D, 3 * D, (bf16*)(ws + WS_WHI), it - T3, false, scr, lane, P.in[1] + (size_t)4 * D); }
    else if (it < T5) { transpose_job(P.in[19], D, D, (bf16*)(ws + WS_WHO), it - T4, false, scr, lane); }
    else if (it < T6) { transpose_job(P.in[21], D, 4128, (bf16*)(ws + WS_WGI), it - T5, false, scr, lane, P.in[1] + (size_t)7 * D); }
    else { transpose_job(P.in[26], D, D, (bf16*)(ws + WS_WGO), it - T6, false, scr, lane); }
}
__device__ __forceinline__ int layer_item_count(int L) { return 2 * I_FI + 2 * I_FO + (L == 2 ? I_GI + I_DD : I_SI + I_DD); }
__device__ __forceinline__ int layer_item(int L, int k) {
    if (k < 2 * I_FI) return 2 * L * I_FI + k;
    k -= 2 * I_FI;
    if (k < 2 * I_FO) return T0 + 2 * L * I_FO + k;
    k -= 2 * I_FO;
    if (L == 1) return T3 + k;
    if (L == 2) return T5 + k;
    const int j = (L == 3) ? 1 : 0;
    return (k < I_SI) ? T1 + j * I_SI + k : T2 + j * I_DD + (k - I_SI);
}
__device__ __forceinline__ void convert_tail(const Params& P, unsigned char* lds, int L, int part) {
    const int tid = ltid(), lane = tid & 63, wave = tid >> 6, c = lbid();
    if (c < 128) return;
    LAS float* scr = (LAS float*)((LAS unsigned char*)lds + wave * 16384);
    const int cnt = layer_item_count(L), lo = part ? cnt / 2 : 0, hi = part ? cnt : cnt / 2;
    for (int k = lo + (c - 128) * NWAVES + wave; k < hi; k += 128 * NWAVES) convert_item(P, layer_item(L, k), scr, lane);
}

__device__ __forceinline__ void prologue(const Params& P, unsigned char* lds, int G) {
    const int tid = ltid(), lane = tid & 63, wave = tid >> 6;
    const int gw = lbid() * NWAVES + wave, ngw = G * NWAVES;
    unsigned char* ws = P.ws;
    LAS float* scr = (LAS float*)((LAS unsigned char*)lds + wave * 16384);
    if (G == 256) { const int cnt = layer_item_count(0); for (int k = gw; k < cnt; k += ngw) convert_item(P, layer_item(0, k), scr, lane); }
    else { for (int it = gw; it < T7; it += ngw) convert_item(P, it, scr, lane); }
    for (int k = lbid() * NTHR + tid; k < FFTN / 2; k += G * NTHR) {
        float s, c; sincospif((float)k * (1.0f / 8192.0f), &s, &c);
        ((f32x2*)(ws + WS_TW))[k] = (f32x2){c, -s};
    }
    {
        const float* w1 = P.in[12]; const float* b1 = P.in[13]; const float* w2 = P.in[14]; const float* b2 = P.in[15]; const float* fr = P.in[17];
        bf16* H2 = (bf16*)(ws + WS_H2);
        const float frq = fr[lane], bb1 = b1[lane], bb2 = b2[lane];
        for (int t = gw; t < SEQ; t += ngw) {
            const float tt = (float)t * (1.0f / (float)(SEQ - 1));
            const float w = (6.283185307179586f * (float)t) / (float)SEQ;
            float z = 0.f;
            if (lane == 0) z = tt;
            else if (lane <= 32) { const int e = (lane - 1) & 15; const float f = 1e-4f + (float)e * ((15.0f - 1e-4f) / 15.0f); const float a = f * w; z = (lane <= 16) ? cosf(a) : -sinf(a); }
            float h1 = bb1;
            for (int e = 0; e < 33; ++e) h1 += __shfl(z, e) * w1[e * 64 + lane];
            h1 = sinf(frq * h1);
            float h2 = bb2;
            for (int j = 0; j < 64; ++j) h2 += __shfl(h1, j) * w2[j * 64 + lane];
            h2 = sinf(frq * h2);
            H2[t * 64 + lane] = (bf16)(pk2(h2, 0.f) & 0xffffu);
        }
        for (int i = lbid() * NTHR + tid; i < 2 * D * 64; i += G * NTHR) { const int c = i >> 6, k = i & 63; ((bf16*)(ws + WS_W3T))[i] = (bf16)(pk2(P.in[16][(size_t)k * (2 * D) + c], 0.f) & 0xffffu); }
    }
    xg_rows(P.in[0], P.in[1], (bf16*)(ws + WS_XN), (float*)(ws + WS_SSQ0), gw, ngw, lane);
}

__device__ __forceinline__ void mul8(const u32x4 a, const u32x4 b, float (&o)[8]) {
    o[0] = bflo(a.x) * bflo(b.x); o[1] = bfhi(a.x) * bfhi(b.x); o[2] = bflo(a.y) * bflo(b.y); o[3] = bfhi(a.y) * bfhi(b.y);
    o[4] = bflo(a.z) * bflo(b.z); o[5] = bfhi(a.z) * bfhi(b.z); o[6] = bflo(a.w) * bflo(b.w); o[7] = bfhi(a.w) * bfhi(b.w);
}
__device__ __forceinline__ void sc_ew(const bf16* PJ, const float* cw, bf16* A2, int G) {
    const int tid = ltid(), d = 8 * (tid & 127), grp = tid >> 7;
    float w0[8], w1[8], w2[8];
#pragma unroll
    for (int i = 0; i < 8; ++i) { w0[i] = cw[d + i]; w1[i] = cw[D + d + i]; w2[i] = cw[2 * D + d + i]; }
    for (int item = lbid(); item < M / 64; item += G) {
        const int m0 = item * 64 + grp * 16, t0 = m0 % SEQ;
        float p[8], c[8], n[8];
        if (t0 > 0) mul8(*(const u32x4*)(PJ + (size_t)(m0 - 1) * 3072 + 1024 + d), *(const u32x4*)(PJ + (size_t)(m0 - 1) * 3072 + 2048 + d), p);
        else {
#pragma unroll
            for (int i = 0; i < 8; ++i) p[i] = 0.f; }
        mul8(*(const u32x4*)(PJ + (size_t)m0 * 3072 + 1024 + d), *(const u32x4*)(PJ + (size_t)m0 * 3072 + 2048 + d), c);
#pragma unroll 4
        for (int r = 0; r < 16; ++r) {
            const int m = m0 + r;
            if (t0 + r + 1 < SEQ) mul8(*(const u32x4*)(PJ + (size_t)(m + 1) * 3072 + 1024 + d), *(const u32x4*)(PJ + (size_t)(m + 1) * 3072 + 2048 + d), n);
            else {
#pragma unroll
                for (int i = 0; i < 8; ++i) n[i] = 0.f; }
            const u32x4 bb = *(const u32x4*)(PJ + (size_t)m * 3072 + d);
            float y[8];
#pragma unroll
            for (int i = 0; i < 8; ++i) y[i] = w0[i] * p[i] + w1[i] * c[i] + w2[i] * n[i];
            u32x4 o;
            o.x = pk2(bflo(bb.x) * y[0], bfhi(bb.x) * y[1]); o.y = pk2(bflo(bb.y) * y[2], bfhi(bb.y) * y[3]); o.z = pk2(bflo(bb.z) * y[4], bfhi(bb.z) * y[5]); o.w = pk2(bflo(bb.w) * y[6], bfhi(bb.w) * y[7]);
            *(u32x4*)(A2 + (size_t)m * D + d) = o;
#pragma unroll
            for (int i = 0; i < 8; ++i) { p[i] = c[i]; c[i] = n[i]; }
        }
    }
}

__device__ __forceinline__ void hy_filter(const bf16* H2, const bf16* w3t, float* hT, int G) {
    const int tid = ltid(), lane = tid & 63, wave = tid >> 6, row = lane & 15, quad = lane >> 4;
    const int gw = lbid() * NWAVES + wave, ngw = G * NWAVES;
    constexpr float MIN_DECAY = -3.0701134573253943f, MAX_DECAY = -15.350567286626972f;
    for (int task = gw; task < (SEQ / 16) * (2 * D / 128); task += ngw) {
        const int t0 = (task % (SEQ / 16)) * 16, cb0 = (task / (SEQ / 16)) * 128;
        const bf16x8 a0 = *(const bf16x8*)(H2 + (size_t)(t0 + row) * 64 + 8 * quad), a1 = *(const bf16x8*)(H2 + (size_t)(t0 + row) * 64 + 32 + 8 * quad);
        float tt[4];
#pragma unroll
        for (int j = 0; j < 4; ++j) tt[j] = (float)(t0 + 4 * quad + j) * (1.0f / (float)(SEQ - 1));
#pragma unroll
        for (int ct = 0; ct < 8; ++ct) {
            const int c = cb0 + 16 * ct + row;
            const bf16x8 b0 = *(const bf16x8*)(w3t + (size_t)c * 64 + 8 * quad), b1 = *(const bf16x8*)(w3t + (size_t)c * 64 + 32 + 8 * quad);
            f32x4 acc = {0.f, 0.f, 0.f, 0.f};
            acc = __builtin_amdgcn_mfma_f32_16x16x32_bf16(a0, b0, acc, 0, 0, 0);
            acc = __builtin_amdgcn_mfma_f32_16x16x32_bf16(a1, b1, acc, 0, 0, 0);
            const float ad = fabsf(MIN_DECAY + (float)(c & (D - 1)) * ((MAX_DECAY - MIN_DECAY) / (float)(D - 1)));
            f32x4 o;
#pragma unroll
            for (int j = 0; j < 4; ++j) o[j] = acc[j] * expf(-tt[j] * ad);
            *(f32x4*)(hT + (size_t)c * SEQ + t0 + 4 * quad) = o;
        }
    }
}
__device__ __forceinline__ void hy_ew1(const bf16* PJ, const float* cw, const float* cb, bf16* X0, unsigned* ZT, unsigned char* lds, int G) {
    const int tid = ltid(), dl = tid & 63, tg = tid >> 6;
    LAS float* zs = (LAS float*)lds;
    for (int item = lbid(); item < (SEQ / 64) * (D / 128); item += G) {
        const int t0 = (item % (SEQ / 64)) * 64, d0 = (item / (SEQ / 64)) * 128, d = d0 + 2 * dl;
        float w[3][3][2], bsv[3][2];
#pragma unroll
        for (int s = 0; s < 3; ++s)
#pragma unroll
            for (int e = 0; e < 2; ++e) { bsv[s][e] = cb[s * D + d + e];
#pragma unroll
                for (int j = 0; j < 3; ++j) w[s][j][e] = cw[j * 3 * D + s * D + d + e]; }
        __syncthreads();
#pragma unroll
        for (int b = 0; b < 2; ++b) {
            unsigned uv[3][10];
#pragma unroll
            for (int i = 0; i < 10; ++i) { const int t = t0 + 8 * tg + i - 1; const bool ok = (t >= 0) && (t < SEQ); const size_t m = (size_t)b * SEQ + (ok ? t : 0);
#pragma unroll
                for (int s = 0; s < 3; ++s) uv[s][i] = ok ? *(const unsigned*)(PJ + m * 3072 + s * D + d) : 0u; }
#pragma unroll
            for (int i = 0; i < 8; ++i) {
                float r[3][2];
#pragma unroll
                for (int s = 0; s < 3; ++s) {
                    r[s][0] = w[s][0][0] * bflo(uv[s][i]) + w[s][1][0] * bflo(uv[s][i + 1]) + w[s][2][0] * bflo(uv[s][i + 2]) + bsv[s][0];
                    r[s][1] = w[s][0][1] * bfhi(uv[s][i]) + w[s][1][1] * bfhi(uv[s][i + 1]) + w[s][2][1] * bfhi(uv[s][i + 2]) + bsv[s][1]; }
                const size_t m = (size_t)b * SEQ + t0 + 8 * tg + i;
                *(unsigned*)(X0 + m * D + d) = pk2(r[0][0], r[0][1]);
                LAS float* zp = zs + (b * 64 + 8 * tg + i) * 129 + 2 * dl;
                zp[0] = r[2][0] * r[1][0]; zp[1] = r[2][1] * r[1][1];
            }
        }
        __syncthreads();
        const int tl = tid & 63, dg = tid >> 6;
#pragma unroll
        for (int i = 0; i < 16; ++i) { const int dd = 16 * dg + i; ZT[(size_t)(d0 + dd) * SEQ + t0 + tl] = pk2(zs[tl * 129 + dd], zs[(64 + tl) * 129 + dd]); }
    }
}
__device__ __forceinline__ void hy_ew2(const unsigned* ZT, const bf16* X0, bf16* A2, unsigned char* lds, int G) {
    const int tid = ltid();
    LAS float* ys = (LAS float*)lds;
    for (int item = lbid(); item < (SEQ / 64) * (D / 128); item += G) {
        const int t0 = (item % (SEQ / 64)) * 64, d0 = (item / (SEQ / 64)) * 128;
        __syncthreads();
        { const int tl = tid & 63, dg = tid >> 6;
#pragma unroll
          for (int i = 0; i < 16; ++i) { const int dd = 16 * dg + i; const unsigned y = ZT[(size_t)(d0 + dd) * SEQ + t0 + tl]; ys[tl * 129 + dd] = bflo(y); ys[(64 + tl) * 129 + dd] = bfhi(y); } }
        __syncthreads();
        { const int dl = tid & 63, tg = tid >> 6;
#pragma unroll
          for (int b = 0; b < 2; ++b)
#pragma unroll
            for (int i = 0; i < 8; ++i) { const size_t m = (size_t)b * SEQ + t0 + 8 * tg + i; const unsigned x0 = *(const unsigned*)(X0 + m * D + d0 + 2 * dl);
                const LAS float* yp = ys + (b * 64 + 8 * tg + i) * 129 + 2 * dl;
                *(unsigned*)(A2 + m * D + d0 + 2 * dl) = pk2(yp[0] * bflo(x0), yp[1] * bfhi(x0)); } }
    }
}

__device__ __forceinline__ f32x2 cmul(f32x2 a, f32x2 b) { return (f32x2){a.x * b.x - a.y * b.y, a.x * b.y + a.y * b.x}; }
__device__ __forceinline__ f32x2 cmulc(f32x2 a, f32x2 b) { return (f32x2){a.x * b.x + a.y * b.y, a.y * b.x - a.x * b.y}; }
__device__ __forceinline__ constexpr float w16c(int i) { return i == 0 ? 1.f : i == 1 ? 0.9238795325112867f : i == 2 ? 0.7071067811865476f : i == 3 ? 0.3826834323650898f : i == 4 ? 0.f : i == 5 ? -0.3826834323650898f : i == 6 ? -0.7071067811865476f : -0.9238795325112867f; }
__device__ __forceinline__ constexpr float w16s(int i) { return i == 0 ? 0.f : i == 1 ? -0.3826834323650898f : i == 2 ? -0.7071067811865476f : i == 3 ? -0.9238795325112867f : i == 4 ? -1.f : i == 5 ? -0.9238795325112867f : i == 6 ? -0.7071067811865476f : -0.3826834323650898f; }
__device__ __forceinline__ int fpad(int i) { return i + (i >> 5); }

template <int R> struct Log2 { static constexpr int v = 1 + Log2<R / 2>::v; };
template <> struct Log2<1> { static constexpr int v = 0; };

template <int R, bool INV, bool UNIT>
__device__ __forceinline__ void bfly(f32x2 (&v)[R], f32x2 base) {
    constexpr int Q = Log2<R>::v;
    f32x2 bp[Q];
    bp[0] = base;
#pragma unroll
    for (int q = 1; q < Q; ++q) bp[q] = cmul(bp[q - 1], bp[q - 1]);
    if constexpr (!INV) {
#pragma unroll
        for (int q = 0; q < Q; ++q) { const int half = R >> (q + 1);
#pragma unroll
            for (int blk = 0; blk < R; blk += 2 * half)
#pragma unroll
                for (int i = 0; i < half; ++i) { const int idx = blk + i; const f32x2 a = v[idx], c = v[idx + half]; v[idx] = a + c; f32x2 dd = a - c;
                    const int ci = i * (8 / half);
                    if (ci != 0) dd = cmul(dd, (f32x2){w16c(ci), w16s(ci)});
                    if (!UNIT) dd = cmul(dd, bp[q]);
                    v[idx + half] = dd; } }
    } else {
#pragma unroll
        for (int q = Q - 1; q >= 0; --q) { const int half = R >> (q + 1);
#pragma unroll
            for (int blk = 0; blk < R; blk += 2 * half)
#pragma unroll
                for (int i = 0; i < half; ++i) { const int idx = blk + i; const f32x2 a = v[idx]; f32x2 c = v[idx + half];
                    const int ci = i * (8 / half);
                    if (ci != 0) c = cmulc(c, (f32x2){w16c(ci), w16s(ci)});
                    if (!UNIT) c = cmulc(c, bp[q]);
                    v[idx] = a + c; v[idx + half] = a - c; } }
    }
}
template <int R, int HP, bool INV>
__device__ __forceinline__ void fft_pass(LAS f32x2* X, const f32x2 base, int tid) {
    constexpr int NBF = FFTN / R;
#pragma unroll 1
    for (int id = tid; id < NBF; id += NTHR) {
        const int j = id & (HP - 1), blk = id / HP, p0 = blk * (R * HP) + j;
        f32x2 v[R];
#pragma unroll
        for (int m = 0; m < R; ++m) v[m] = X[fpad(p0 + m * HP)];
        bfly<R, INV, false>(v, base);
#pragma unroll
        for (int m = 0; m < R; ++m) X[fpad(p0 + m * HP)] = v[m];
    }
}

template <bool STORE> __device__ __forceinline__ void hy_fft(const float* hT, const float* dbias, unsigned* ZT, const f32x2* TW, unsigned char* lds, int G) {
    const int tid = ltid();
    LAS f32x2* X = (LAS f32x2*)lds;
    const f32x2 twA0 = TW[tid], twA1 = TW[tid + NTHR], twB = TW[(tid & 63) * 16], twC = TW[(tid & 7) * 256];
    for (int d = lbid(); d < D; d += G) {
        f32x2 Hf[4][8];
        __syncthreads();
#pragma unroll 1
        for (int r = 0; r < 2; ++r) { const int j = tid + NTHR * r; f32x2 v[16];
#pragma unroll
            for (int m = 0; m < 16; ++m) { const int p = j + m * 1024; float val;
                if (m < 8) { val = hT[(size_t)d * SEQ + p]; if (p == 0) val += dbias[d]; }
                else if (p == SEQ) val = 0.f;
                else val = hT[(size_t)(D + d) * SEQ + (2 * SEQ - p)];
                v[m] = (f32x2){val, 0.f}; }
            bfly<16, false, false>(v, r ? twA1 : twA0);
#pragma unroll
            for (int m = 0; m < 16; ++m) X[fpad(j + m * 1024)] = v[m]; }
        __syncthreads();
        fft_pass<16, 64, false>(X, twB, tid); __syncthreads();
        fft_pass<8, 8, false>(X, twC, tid); __syncthreads();
#pragma unroll
        for (int r = 0; r < 4; ++r) { const int id = tid + NTHR * r; f32x2 v[8];
#pragma unroll
            for (int m = 0; m < 8; ++m) v[m] = X[fpad(id * 8 + m)];
            bfly<8, false, true>(v, (f32x2){1.f, 0.f});
#pragma unroll
            for (int m = 0; m < 8; ++m) Hf[r][m] = v[m] * (1.0f / (float)FFTN); }
        __syncthreads();
#pragma unroll 1
        for (int r = 0; r < 2; ++r) { const int j = tid + NTHR * r; f32x2 v[16];
#pragma unroll
            for (int m = 0; m < 16; ++m) { if (m < 8) { const unsigned z = ZT[(size_t)d * SEQ + j + m * 1024]; v[m] = (f32x2){bflo(z), bfhi(z)}; } else v[m] = (f32x2){0.f, 0.f}; }
            bfly<16, false, false>(v, r ? twA1 : twA0);
#pragma unroll
            for (int m = 0; m < 16; ++m) X[fpad(j + m * 1024)] = v[m]; }
        __syncthreads();
        fft_pass<16, 64, false>(X, twB, tid); __syncthreads();
        fft_pass<8, 8, false>(X, twC, tid); __syncthreads();
#pragma unroll
        for (int r = 0; r < 4; ++r) { const int id = tid + NTHR * r; f32x2 v[8];
#pragma unroll
            for (int m = 0; m < 8; ++m) v[m] = X[fpad(id * 8 + m)];
            bfly<8, false, true>(v, (f32x2){1.f, 0.f});
#pragma unroll
            for (int m = 0; m < 8; ++m) v[m] = cmul(v[m], Hf[r][m]);
            bfly<8, true, true>(v, (f32x2){1.f, 0.f});
#pragma unroll
            for (int m = 0; m < 8; ++m) X[fpad(id * 8 + m)] = v[m]; }
        __syncthreads();
        fft_pass<8, 8, true>(X, twC, tid); __syncthreads();
        fft_pass<16, 64, true>(X, twB, tid); __syncthreads();
#pragma unroll 1
        for (int r = 0; r < 2; ++r) { const int j = tid + NTHR * r; f32x2 v[16];
#pragma unroll
            for (int m = 0; m < 16; ++m) v[m] = X[fpad(j + m * 1024)];
            bfly<16, true, false>(v, r ? twA1 : twA0);
#pragma unroll
            for (int m = 0; m < 8; ++m) if (STORE || v[m].x == 123.456f) ZT[(size_t)d * SEQ + j + m * 1024] = pk2(v[m].x, v[m].y); }
    }
}

__device__ __forceinline__ void gd_prep(const bf16* PJ3, const float* AB, const float* cw, const float* alog, const float* dtb, bf16* QKV, float* Gd, float* Bd, int G) {
    const int tid = ltid(), lane = tid & 63, wave = tid >> 6;
    const int gw = lbid() * NWAVES + wave, ngw = G * NWAVES;
    for (int task = gw; task < (M / 8) * GH; task += ngw) {
        const int h = task & 7, m0 = (task >> 3) * 8, t0 = m0 % SEQ;
        float wgt[3][3][2]; unsigned prv[3], cur[3];
#pragma unroll
        for (int s = 0; s < 3; ++s) { const int col = s * D + h * GDK + 2 * lane;
#pragma unroll
            for (int j = 0; j < 3; ++j) { wgt[s][j][0] = cw[j * 3072 + col]; wgt[s][j][1] = cw[j * 3072 + col + 1]; }
            prv[s] = (t0 > 0) ? *(const unsigned*)(PJ3 + (size_t)(m0 - 1) * 3072 + col) : 0u;
            cur[s] = *(const unsigned*)(PJ3 + (size_t)m0 * 3072 + col); }
#pragma unroll 4
        for (int r = 0; r < 8; ++r) {
            const int m = m0 + r; unsigned nxt[3]; float o[3][2];
#pragma unroll
            for (int s = 0; s < 3; ++s) { const int col = s * D + h * GDK + 2 * lane;
                nxt[s] = (t0 + r + 1 < SEQ) ? *(const unsigned*)(PJ3 + (size_t)(m + 1) * 3072 + col) : 0u;
                o[s][0] = silu_f(wgt[s][0][0] * bflo(prv[s]) + wgt[s][1][0] * bflo(cur[s]) + wgt[s][2][0] * bflo(nxt[s]));
                o[s][1] = silu_f(wgt[s][0][1] * bfhi(prv[s]) + wgt[s][1][1] * bfhi(cur[s]) + wgt[s][2][1] * bfhi(nxt[s]));
                prv[s] = cur[s]; cur[s] = nxt[s]; }
            const float sq = wave_sum(o[0][0] * o[0][0] + o[0][1] * o[0][1]), sk = wave_sum(o[1][0] * o[1][0] + o[1][1] * o[1][1]);
            const float rq = rsqrtf(sq + 1e-6f) * 0.08838834764831845f, rk = rsqrtf(sk + 1e-6f);
            const size_t off = (size_t)m * D + h * GDK + 2 * lane;
            *(unsigned*)(QKV + off) = pk2(o[0][0] * rq, o[0][1] * rq);
            *(unsigned*)(QKV + (size_t)M * D + off) = pk2(o[1][0] * rk, o[1][1] * rk);
            *(unsigned*)(QKV + 2 * (size_t)M * D + off) = pk2(o[2][0], o[2][1]);
        }
    }
    for (int i = lbid() * NTHR + tid; i < M * 16; i += G * NTHR) {
        const int m = i >> 4, e = i & 15, dir = e >> 3, h = e & 7;
        const float a = AB[(size_t)m * 32 + e], b = AB[(size_t)m * 32 + 16 + e];
        const float xx = a + dtb[e];
        const float sp = xx > 20.f ? xx : log1pf(expf(xx));
        Gd[((size_t)dir * M + m) * 8 + h] = -expf(alog[e]) * sp;
        Bd[((size_t)dir * M + m) * 8 + h] = 1.f / (1.f + expf(-b));
    }
}

__device__ __forceinline__ int gd_token(int dir, int b, int p) { return b * SEQ + (dir ? (SEQ - 1 - p) : p); }

__device__ __forceinline__ void lds_barrier() { asm volatile("s_waitcnt lgkmcnt(0)" ::: "memory"); __builtin_amdgcn_s_barrier(); asm volatile("" ::: "memory"); }

__device__ __forceinline__ void gd_chunk(const bf16* QKV, const float* Gd, const float* Bd, unsigned char* big, unsigned char* lds_, int G) {
    const int tid = ltid(), lane = tid & 63, wave = __builtin_amdgcn_readfirstlane(tid >> 6), row = lane & 15, quad = lane >> 4;
    LAS unsigned char* lds = (LAS unsigned char*)lds_;
    constexpr int RS = 136, AST = 72, XST = 72;
    LAS bf16* qs = (LAS bf16*)lds; LAS bf16* ks = qs + 64 * RS; LAS bf16* vs = ks + 64 * RS;
    LAS float* As = (LAS float*)(lds + 3 * 64 * RS * 2);
    LAS float* gcs = As + 64 * 68;
    LAS float* bes = gcs + 64;
    LAS bf16* Asb = (LAS bf16*)(bes + 64);
    LAS bf16* Xt = Asb + 64 * AST;
    LAS float* Cw = (LAS float*)(Xt + 256 * XST) + (wave & 3) * (16 * 65);
    bf16* Wc = (bf16*)(big + CH_W); bf16* QD = (bf16*)(big + CH_QD); bf16* KDT = (bf16*)(big + CH_KDT); bf16* UT = (bf16*)(big + CH_UT); bf16* AT = (bf16*)(big + CH_AT);
    float* GT = (float*)(big + BIG_GT);
    constexpr int NCID = 2 * NB * GH * GNCH;
    u32x4 pf[6]; float gpre = 0.f, bpre = 0.f;
#define CHUNK_PREFETCH(cid_) do { const int n_ = (cid_) & (GNCH - 1), h_ = ((cid_) >> 7) & 7, b_ = ((cid_) >> 10) & 1, dir_ = (cid_) >> 11; \
        _Pragma("unroll") for (int i_ = 0; i_ < 6; ++i_) { const int e_ = tid + NTHR * i_, s_ = e_ >> 10, r_ = (e_ >> 4) & 63, pc_ = e_ & 15; const int m_ = gd_token(dir_, b_, 64 * n_ + r_); \
            pf[i_] = *(const u32x4*)(QKV + (size_t)s_ * M * D + (size_t)m_ * D + h_ * GDK + pc_ * 8); } \
        if (tid < 64) { const int m_ = gd_token(dir_, b_, 64 * n_ + tid); gpre = Gd[((size_t)dir_ * M + m_) * 8 + h_]; bpre = Bd[((size_t)dir_ * M + m_) * 8 + h_]; } } while (0)
    if (lbid() < NCID) CHUNK_PREFETCH(lbid());
    for (int cid = lbid(); cid < NCID; cid += G) {
        lds_barrier();
#pragma unroll
        for (int i = 0; i < 6; ++i) { const int e = tid + NTHR * i, s_ = e >> 10, r = (e >> 4) & 63, pc = e & 15; *(LAS u32x4*)(qs + s_ * 64 * RS + r * RS + pc * 8) = pf[i]; }
        if (tid < 64) { float g = gpre;
#pragma unroll
            for (int o = 1; o < 64; o <<= 1) { const float t = __shfl_up(g, o); if (lane >= o) g += t; }
            gcs[tid] = g; bes[tid] = bpre;
            if (tid == 63) GT[cid] = __expf(g); }
        lds_barrier();
        if (cid + G < NCID) CHUNK_PREFETCH(cid + G);
        { const int mt = wave & 3, nt0 = 2 * (wave >> 2);
          f32x4 kk[2] = {{0.f, 0.f, 0.f, 0.f}, {0.f, 0.f, 0.f, 0.f}}, qk[2] = {{0.f, 0.f, 0.f, 0.f}, {0.f, 0.f, 0.f, 0.f}};
#pragma unroll
          for (int kst = 0; kst < 4; ++kst) {
              const bf16x8 ak = *(const LAS bf16x8*)(ks + (16 * mt + row) * RS + 32 * kst + 8 * quad), aq = *(const LAS bf16x8*)(qs + (16 * mt + row) * RS + 32 * kst + 8 * quad);
#pragma unroll
              for (int nn = 0; nn < 2; ++nn) { const bf16x8 bk = *(const LAS bf16x8*)(ks + (16 * (nt0 + nn) + row) * RS + 32 * kst + 8 * quad);
                  kk[nn] = __builtin_amdgcn_mfma_f32_16x16x32_bf16(ak, bk, kk[nn], 0, 0, 0); qk[nn] = __builtin_amdgcn_mfma_f32_16x16x32_bf16(aq, bk, qk[nn], 0, 0, 0); } }
#pragma unroll
          for (int nn = 0; nn < 2; ++nn)
#pragma unroll
              for (int j = 0; j < 4; ++j) { const int c = 16 * mt + 4 * quad + j, s_ = 16 * (nt0 + nn) + row;
                  const float dg = (s_ <= c) ? (gcs[c] - gcs[s_]) : 0.f; const float dec = __expf(dg);
                  const float av = (s_ < c) ? bes[c] * kk[nn][j] * dec : 0.f;
                  As[s_ * 68 + c] = av;
                  Asb[c * AST + s_] = (bf16)(pk2(av, 0.f) & 0xffffu);
                  AT[(size_t)cid * 4096 + (((c >> 4) * 2 + (s_ >> 5)) * 64 + (c & 15) + 16 * ((s_ & 31) >> 3)) * 8 + (s_ & 7)] = (bf16)(pk2((s_ <= c) ? qk[nn][j] * dec : 0.f, 0.f) & 0xffffu); } }
        if (tid < 256) {
#pragma unroll
            for (int i = 0; i < 8; ++i) *(LAS u32x4*)(Xt + tid * XST + 8 * i) = (u32x4){0u, 0u, 0u, 0u}; }
        lds_barrier();
        if (tid < 256) {
            const int col = tid; const bool isw = col >= 128; const LAS bf16* src = isw ? (ks + (col - 128)) : (vs + col);
#pragma unroll 1
            for (int blk = 0; blk < 4; ++blk) {
                float R[16];
#pragma unroll
                for (int r = 0; r < 16; ++r) { const int c = 16 * blk + r; float a = bf2f(src[c * RS]) * bes[c]; if (isw) a *= __expf(gcs[c]); R[r] = a; }
                if (blk > 0) {
#pragma unroll
                    for (int ct = 0; ct < 4; ++ct) {
                        f32x4 acc = {0.f, 0.f, 0.f, 0.f};
                        { const bf16x8 a0 = *(const LAS bf16x8*)(Asb + (16 * blk + row) * AST + 8 * quad), b0 = *(const LAS bf16x8*)(Xt + (64 * wave + 16 * ct + row) * XST + 8 * quad);
                          acc = __builtin_amdgcn_mfma_f32_16x16x32_bf16(a0, b0, acc, 0, 0, 0); }
                        if (blk == 3) { const bf16x8 a1 = *(const LAS bf16x8*)(Asb + (16 * blk + row) * AST + 32 + 8 * quad), b1 = *(const LAS bf16x8*)(Xt + (64 * wave + 16 * ct + row) * XST + 32 + 8 * quad);
                          acc = __builtin_amdgcn_mfma_f32_16x16x32_bf16(a1, b1, acc, 0, 0, 0); }
#pragma unroll
                        for (int j = 0; j < 4; ++j) Cw[(4 * quad + j) * 65 + 16 * ct + row] = acc[j];
                    }
                    asm volatile("s_waitcnt lgkmcnt(0)" ::: "memory");
#pragma unroll
                    for (int r = 0; r < 16; ++r) R[r] -= Cw[r * 65 + lane];
                }
#pragma unroll
                for (int sl = 0; sl < 15; ++sl) {
                    const float xs = R[sl];
                    const LAS f32x4* ap = (const LAS f32x4*)(As + (16 * blk + sl) * 68 + 16 * blk);
                    f32x4 av[4];
#pragma unroll
                    for (int q = 0; q < 4; ++q) if (4 * q + 3 > sl) av[q] = ap[q];
#pragma unroll
                    for (int r = sl + 1; r < 16; ++r) R[r] -= av[r >> 2][r & 3] * xs;
                }
                u32x4 w0, w1;
                w0.x = pk2(R[0], R[1]); w0.y = pk2(R[2], R[3]); w0.z = pk2(R[4], R[5]); w0.w = pk2(R[6], R[7]);
                w1.x = pk2(R[8], R[9]); w1.y = pk2(R[10], R[11]); w1.z = pk2(R[12], R[13]); w1.w = pk2(R[14], R[15]);
                if (blk < 3) { *(LAS u32x4*)(Xt + col * XST + 16 * blk) = w0; *(LAS u32x4*)(Xt + col * XST + 16 * blk + 8) = w1; asm volatile("s_waitcnt lgkmcnt(0)" ::: "memory"); }
                if (!isw) {
                    bf16* up = UT + (size_t)cid * 8192 + (((col >> 4) * 4 + blk) * 64 + (col & 15)) * 4;
                    *(u32x2*)up = (u32x2){w0.x, w0.y}; *(u32x2*)(up + 64) = (u32x2){w0.z, w0.w}; *(u32x2*)(up + 128) = (u32x2){w1.x, w1.y}; *(u32x2*)(up + 192) = (u32x2){w1.z, w1.w};
                } else {
                    const int dk = col - 128;
                    bf16* wp = Wc + (size_t)cid * 8192 + ((blk * 4 + (dk >> 5)) * 64 + 16 * ((dk & 31) >> 3)) * 8 + (dk & 7);
#pragma unroll
                    for (int r = 0; r < 16; ++r) wp[r * 8] = (bf16)(pk2(R[r], 0.f) & 0xffffu);
                }
            }
        } else {
            const int t2 = tid - 256;
#pragma unroll
            for (int i = 0; i < 4; ++i) { const int pc = t2 + 256 * i, c = pc >> 4, d8 = (pc & 15) * 8; const float e = __expf(gcs[c]);
                const u32x4 qv = *(const LAS u32x4*)(qs + c * RS + d8); u32x4 w;
                w.x = pk2(bflo(qv.x) * e, bfhi(qv.x) * e); w.y = pk2(bflo(qv.y) * e, bfhi(qv.y) * e); w.z = pk2(bflo(qv.z) * e, bfhi(qv.z) * e); w.w = pk2(bflo(qv.w) * e, bfhi(qv.w) * e);
                *(u32x4*)(QD + (size_t)cid * 8192 + (((c >> 4) * 4 + (d8 >> 5)) * 64 + (c & 15) + 16 * ((d8 & 31) >> 3)) * 8) = w; }
            const int dk = t2 & 127, chf = t2 >> 7; const float glast = gcs[63];
#pragma unroll
            for (int c8 = 0; c8 < 4; ++c8) { float x[8];
#pragma unroll
                for (int q = 0; q < 8; ++q) { const int c = 32 * chf + 8 * c8 + q; x[q] = bf2f(ks[c * RS + dk]) * __expf(glast - gcs[c]); }
                u32x4 w; w.x = pk2(x[0], x[1]); w.y = pk2(x[2], x[3]); w.z = pk2(x[4], x[5]); w.w = pk2(x[6], x[7]);
                *(u32x4*)(KDT + (size_t)cid * 8192 + (((dk >> 4) * 2 + chf) * 64 + (dk & 15) + 16 * c8) * 8) = w; }
        }
    }
#undef CHUNK_PREFETCH
}

struct ScanStage { bf16x8 P[4], A[2], K[2]; u32x2 u; };
__device__ __forceinline__ void scan_load(ScanStage& s, const bf16* Pm, const bf16* AT, const bf16* KDT, const bf16* UT, size_t cid, int mt, int wave, int slice, int row, int quad) {
    const int lane = row + 16 * quad;
#pragma unroll
    for (int k = 0; k < 4; ++k) s.P[k] = *(const bf16x8*)(Pm + cid * 8192 + ((mt * 4 + k) * 64 + lane) * 8);
#pragma unroll
    for (int k = 0; k < 2; ++k) s.K[k] = *(const bf16x8*)(KDT + cid * 8192 + ((wave * 2 + k) * 64 + lane) * 8);
    if (wave < 4) s.u = *(const u32x2*)(UT + cid * 8192 + ((slice * 4 + mt) * 64 + lane) * 4);
    else {
#pragma unroll
        for (int k = 0; k < 2; ++k) s.A[k] = *(const bf16x8*)(AT + cid * 4096 + ((mt * 2 + k) * 64 + lane) * 8); }
}
template <int VAR> __device__ __forceinline__ void scan_step(const ScanStage& s, float gt, f32x4& Sacc, LAS bf16* St, LAS bf16* Vt, bf16* Orow0, int ostride, bool lead, int mt, int wave, int row, int quad) {
    constexpr int SS = 136, VS = 72;
    f32x4 acc = {0.f, 0.f, 0.f, 0.f};
#pragma unroll
    for (int k = 0; k < 4; ++k) { const bf16x8 sb = *(const LAS bf16x8*)(St + row * SS + 32 * k + 8 * quad); acc = __builtin_amdgcn_mfma_f32_16x16x32_bf16(s.P[k], sb, acc, 0, 0, 0); }
    if (lead) {
        const float v0 = bflo(s.u.x) - acc[0], v1 = bfhi(s.u.x) - acc[1], v2 = bflo(s.u.y) - acc[2], v3 = bfhi(s.u.y) - acc[3];
        u32x2 w; w.x = pk2(v0, v1); w.y = pk2(v2, v3);
        *(LAS u32x2*)(Vt + row * VS + 16 * mt + 4 * quad) = w;
    }
    lds_barrier();
    bf16x8 vb[2];
#pragma unroll
    for (int k = 0; k < 2; ++k) vb[k] = *(const LAS bf16x8*)(Vt + row * VS + 32 * k + 8 * quad);
    if (!lead) {
#pragma unroll
        for (int k = 0; k < 2; ++k) acc = __builtin_amdgcn_mfma_f32_16x16x32_bf16(s.A[k], vb[k], acc, 0, 0, 0);
#pragma unroll
        for (int j = 0; j < 4; ++j) if (VAR == 0) Orow0[(ptrdiff_t)(4 * quad + j) * ostride] = (bf16)(pk2(acc[j], 0.f) & 0xffffu);
        if (VAR != 0) Sacc += acc * 1e-30f;
    }
    Sacc = Sacc * gt;
#pragma unroll
    for (int k = 0; k < 2; ++k) Sacc = __builtin_amdgcn_mfma_f32_16x16x32_bf16(s.K[k], vb[k], Sacc, 0, 0, 0);
    { u32x2 w; w.x = pk2(Sacc[0], Sacc[1]); w.y = pk2(Sacc[2], Sacc[3]); *(LAS u32x2*)(St + row * SS + 16 * wave + 4 * quad) = w; }
    lds_barrier();
}
template <int VAR> __device__ __forceinline__ void gd_scan(unsigned char* big, bf16* O, unsigned char* lds_, int G, unsigned* ctl) {
    const int tid = ltid(), lane = tid & 63, wave = __builtin_amdgcn_readfirstlane(tid >> 6), row = lane & 15, quad = lane >> 4;
    LAS unsigned char* lds = (LAS unsigned char*)lds_;
    constexpr int SS = 136;
    LAS bf16* St = (LAS bf16*)lds; LAS bf16* Vt = St + 16 * SS; LAS float* gts = (LAS float*)(lds + 8192);
    const bf16* Wc = (const bf16*)(big + CH_W); const bf16* QD = (const bf16*)(big + CH_QD); const bf16* KDT = (const bf16*)(big + CH_KDT); const bf16* UT = (const bf16*)(big + CH_UT); const bf16* AT = (const bf16*)(big + CH_AT);
    const float* GT = (const float*)(big + BIG_GT);
    const int mt = wave & 3; const bool lead = wave < 4;
    int t0 = lbid(), tstride = G;
    { volatile LAS unsigned* misc = (volatile LAS unsigned*)(lds + LDS_MISC); const unsigned li = misc[2], xc = misc[3]; bool ok = (G == 256) && xc < 8u && li < 32u;
#pragma unroll
      for (int j = 0; j < 8; ++j) ok = ok && (xb_ld(&ctl[XB_XCNT(j)]) == 32u);
      if (ok) { t0 = (int)((li << 3) | xc); tstride = 256; } }
    for (int task = t0; task < 2 * NB * GH * 8; task += tstride) {
        const int slice = (task >> 3) & 7, chain = (task & 7) * 4 + (task >> 6), h = chain & 7, b = (chain >> 3) & 1, dir = chain >> 4;
        __syncthreads();
        for (int e = tid; e < 16 * SS; e += NTHR) St[e] = 0;
        if (tid < GNCH) gts[tid] = GT[(size_t)((task & 7) * 4 + (task >> 6)) * GNCH + tid];
        f32x4 Sacc = {0.f, 0.f, 0.f, 0.f};
        __syncthreads();
        const bf16* Pm = lead ? Wc : QD;
        const size_t cid0 = (VAR == 3) ? (size_t)0 : (size_t)chain * GNCH;
        const int ostride = dir ? -D : D;
        bf16* Obase = O + ((size_t)dir * M + gd_token(dir, b, 16 * mt)) * D + h * GDK + slice * 16 + row;
        ScanStage s0, s1, s2;
        scan_load(s0, Pm, AT, KDT, UT, cid0 + 0, mt, wave, slice, row, quad);
        scan_load(s1, Pm, AT, KDT, UT, cid0 + 1, mt, wave, slice, row, quad);
        scan_load(s2, Pm, AT, KDT, UT, cid0 + 2, mt, wave, slice, row, quad);
#pragma unroll 1
        for (int n = 0; n < GNCH - 2; n += 3) {
            const int n3 = (n + 3 < GNCH - 2) ? n + 3 : GNCH - 3;
            scan_step<VAR>(s0, gts[n + 0], Sacc, St, Vt, Obase + (ptrdiff_t)(64 * (n + 0)) * ostride, ostride, lead, mt, wave, row, quad);
            if (VAR != 1) scan_load(s0, Pm, AT, KDT, UT, cid0 + n3 + 0, mt, wave, slice, row, quad);
            scan_step<VAR>(s1, gts[n + 1], Sacc, St, Vt, Obase + (ptrdiff_t)(64 * (n + 1)) * ostride, ostride, lead, mt, wave, row, quad);
            if (VAR != 1) scan_load(s1, Pm, AT, KDT, UT, cid0 + n3 + 1, mt, wave, slice, row, quad);
            scan_step<VAR>(s2, gts[n + 2], Sacc, St, Vt, Obase + (ptrdiff_t)(64 * (n + 2)) * ostride, ostride, lead, mt, wave, row, quad);
            if (VAR != 1) scan_load(s2, Pm, AT, KDT, UT, cid0 + n3 + 2, mt, wave, slice, row, quad);
        }
        scan_step<VAR>(s1, gts[GNCH - 2], Sacc, St, Vt, Obase + (ptrdiff_t)(64 * (GNCH - 2)) * ostride, ostride, lead, mt, wave, row, quad);
        scan_step<VAR>(s2, gts[GNCH - 1], Sacc, St, Vt, Obase + (ptrdiff_t)(64 * (GNCH - 1)) * ostride, ostride, lead, mt, wave, row, quad);
        if (VAR != 0 && Sacc[0] == 123.456f) ctl[4000] = 1u;
    }
}

__device__ __forceinline__ void gd_post(const bf16* O, const bf16* Z, const float* ng, bf16* A2, int G) {
    const int tid = ltid(), lane = tid & 63, wave = tid >> 6;
    const int gw = lbid() * NWAVES + wave, ngw = G * NWAVES;
    const float g0 = ng[2 * lane], g1 = ng[2 * lane + 1];
#pragma unroll 4
    for (int task = gw; task < M * GH; task += ngw) {
        const int m = task >> 3, h = task & 7; const size_t off = (size_t)m * D + h * GDK + 2 * lane;
        const unsigned a = *(const unsigned*)(O + off), bq = *(const unsigned*)(O + (size_t)M * D + off), z = *(const unsigned*)(Z + off);
        const float o0 = bflo(a) + bflo(bq), o1 = bfhi(a) + bfhi(bq);
        const float rstd = rsqrtf(wave_sum(o0 * o0 + o1 * o1) * (1.f / GDK) + NORM_EPS);
        *(unsigned*)(A2 + off) = pk2(o0 * rstd * g0 * silu_f(bflo(z)), o1 * rstd * g1 * silu_f(bfhi(z)));
    }
}

constexpr int LDS_RS = 131072;
__device__ __forceinline__ void rs_prefill(const pg8::StaticOrder& S, const float* ssq, unsigned char* lds) {
    const int tid = ltid(); LAS float* rsb = (LAS float*)((LAS unsigned char*)lds + LDS_RS);
    pg8::Unit u;
    for (int i = 0; i < 6 && S.next(i, u); ++i) {
        const int r = tid >> 1; const f32x4* p = (const f32x4*)(ssq + (size_t)(u.pm * 256 + r) * 16 + (tid & 1) * 8);
        const f32x4 a = p[0], b = p[1]; float t = ((a[0] + a[1]) + (a[2] + a[3])) + ((b[0] + b[1]) + (b[2] + b[3]));
        t += __shfl_xor(t, 1);
        if ((tid & 1) == 0) rsb[i * 256 + r] = rsqrtf(t * (1.0f / D) + NORM_EPS);
    }
    __syncthreads();
}

__device__ __forceinline__ void vec_prefill(const float* gain, const float* bias, unsigned char* lds) {
    const int tid = ltid(); LAS float* t = (LAS float*)((LAS unsigned char*)lds + LDS_RS);
    for (int i = tid; i < D; i += NTHR) { t[i] = gain[i]; t[D + i] = bias ? bias[i] : 0.f; }
    __syncthreads();
}

constexpr int N_PHASES = 35;
enum { T_PRO = 0, T_G1, T_G2, T_NORM, T_PJ, T_SCEW, T_RES, T_HYEW1, T_HYFFT, T_HYEW2, T_GDPJ, T_GDPREP, T_GDCHUNK, T_GDSCAN, T_GDPOST };

__device__ __forceinline__ int run_phase(int ph, const Params& P, unsigned char* lds, int G_) {
    int G = G_; asm volatile("" : "+s"(G));
    unsigned char* ws = P.ws; unsigned char* big = ws + WS_BIG;
    const int tid = ltid(), lane = tid & 63, wave = tid >> 6;
    const int gw = lbid() * NWAVES + wave, ngw = G * NWAVES;
    int type, layer = 0, half = 0;
    if (ph == 0) type = T_PRO;
    else if (ph == N_PHASES - 1) type = T_NORM;
    else {
        const int p = ph - 1;
        layer = (p >= 26) ? 3 : (p >= 16) ? 2 : (p >= 7) ? 1 : 0;
        const int start = (layer == 3) ? 26 : (layer == 2) ? 16 : (layer == 1) ? 7 : 0, len = (layer == 1) ? 9 : (layer == 2) ? 10 : 7;
        const int q = p - start, mix = layer % 3;
        if (q < 2) { half = 0; type = (q == 0) ? T_G1 : T_G2; }
        else if (q >= len - 2) { half = 1; type = (q == len - 2) ? T_G1 : T_G2; }
        else { const int r = q - 2, mlen = len - 4;
            if (r == mlen - 1) type = T_RES;
            else if (mix == 0) type = (r == 0) ? T_PJ : T_SCEW;
            else if (mix == 1) type = (r == 0) ? T_PJ : (r == 1) ? T_HYEW1 : (r == 2) ? T_HYFFT : T_HYEW2;
            else type = (r == 0) ? T_GDPJ : (r == 1) ? T_GDPREP : (r == 2) ? T_GDCHUNK : (r == 3) ? T_GDSCAN : T_GDPOST; }
    }
    const int mix = layer % 3, mj = layer / 3;
    bf16* XN = (bf16*)(ws + WS_XN); bf16* A2 = (bf16*)(ws + WS_A2);
#define SSQ_OF(k) ((float*)(ws + (((k) & 1) ? WS_SSQ1 : WS_SSQ0)))
    PG8_LAS unsigned char* glds = (PG8_LAS unsigned char*)lds;
    switch (type) {
    case T_PRO: prologue(P, lds, G); break;
    case T_G1: {
        pg8::Gemm g{XN, (const bf16*)(ws + WS_WFI) + (size_t)(layer * 2 + half) * FF2 * D, M, FF2, D, D, 128, D, 128}; pg8::StaticOrder S; S.init(M, FF2, G, lbid());
        rs_prefill(S, SSQ_OF(layer * 3 + (half ? 2 : 0)), lds);
        EpiSwiglu E{(bf16*)big, (const LAS float*)((LAS unsigned char*)lds + LDS_RS)};
        pg8::gemm_phase<EpiSwiglu, pg8::StaticOrder, true, true>(glds, g, S, E);
        if (G == 256 && layer < 3) convert_tail(P, lds, layer + 1, half);
    } break;
    case T_G2: {
        pg8::Gemm g{(const bf16*)big, (const bf16*)(ws + WS_WFO) + (size_t)(layer * 2 + half) * D * FF, M, D, FF, 64, (size_t)M * 128, 64, (size_t)D * 128}; pg8::StaticOrder S; S.init(M, D, G, lbid());
        const int nk = half ? (layer + 1) * 3 : layer * 3 + 1;
        EpiResid E{XN, nullptr, 1, SSQ_OF(nk)};
        pg8::gemm_phase<EpiResid, pg8::StaticOrder, false, true>(glds, g, S, E);
    } break;
    case T_NORM: final_rows(XN, P.out, P.in[2], SSQ_OF(12), gw, ngw, lane); break;
    case T_PJ: {
        const bf16* W = (mix == 0) ? (const bf16*)(ws + WS_WSI) + (size_t)mj * 3 * D * D : (const bf16*)(ws + WS_WHI);
        pg8::Gemm g{XN, W, M, 3 * D, D, D, 128, D, 128}; pg8::StaticOrder S; S.init(M, 3 * D, G, lbid());
        rs_prefill(S, SSQ_OF(layer * 3 + 1), lds);
        EpiProj E{(bf16*)big, 3 * D, (mix == 1) ? P.in[9] : nullptr, (const LAS float*)((LAS unsigned char*)lds + LDS_RS)};
        pg8::gemm_phase<EpiProj, pg8::StaticOrder, true, true>(glds, g, S, E);
    } break;
    case T_SCEW: sc_ew((const bf16*)big, P.in[6] + (size_t)mj * 3 * D, A2, G); break;
    case T_RES: {
        const bf16* W = (mix == 0) ? (const bf16*)(ws + WS_WSO) + (size_t)mj * D * D : (mix == 1) ? (const bf16*)(ws + WS_WHO) : (const bf16*)(ws + WS_WGO);
        pg8::Gemm g{A2, W, M, D, D, D, 128, D, 128}; pg8::StaticOrder S; S.init(M, D, G, lbid());
        const int nk = layer * 3 + 2;
        if (mix == 1) vec_prefill(P.in[20], P.in[20], lds);
        const LAS float* gl = (const LAS float*)((LAS unsigned char*)lds + LDS_RS);
        EpiResid E{XN, (mix == 1) ? gl + D : nullptr, 0, SSQ_OF(nk)};
        pg8::gemm_phase<EpiResid, pg8::StaticOrder, false, true>(glds, g, S, E);
    } break;
    case T_HYEW1:
        hy_filter((const bf16*)(ws + WS_H2), (const bf16*)(ws + WS_W3T), (float*)(big + BIG_HT), G);
        hy_ew1((const bf16*)big, P.in[10], P.in[11], (bf16*)(big + BIG_X0), (unsigned*)(big + BIG_ZT), lds, G);
        break;
    case T_HYFFT: hy_fft<true>((const float*)(big + BIG_HT), P.in[18], (unsigned*)(big + BIG_ZT), (const f32x2*)(ws + WS_TW), lds, G); break;
    case T_HYEW2: hy_ew2((const unsigned*)(big + BIG_ZT), (const bf16*)(big + BIG_X0), A2, lds, G); break;
    case T_GDPJ: {
        pg8::Gemm g{XN, (const bf16*)(ws + WS_WGI), M, NGD, D, D, 128, D, 128}; pg8::StaticOrder S; S.init(M, NGD, G, lbid());
        rs_prefill(S, SSQ_OF(layer * 3 + 1), lds);
        EpiGD E{(bf16*)big, (bf16*)(big + BIG_Z), (float*)(big + BIG_AB), (const LAS float*)((LAS unsigned char*)lds + LDS_RS)};
        pg8::gemm_phase<EpiGD, pg8::StaticOrder, true, true>(glds, g, S, E);
    } break;
    case T_GDPREP: gd_prep((const bf16*)big, (const float*)(big + BIG_AB), P.in[22], P.in[23], P.in[24], (bf16*)(big + BIG_QKV), (float*)(big + BIG_G), (float*)(big + BIG_G + MiB), G); break;
    case T_GDCHUNK: gd_chunk((const bf16*)(big + BIG_QKV), (const float*)(big + BIG_G), (const float*)(big + BIG_G + MiB), big, lds, G); break;
    case T_GDSCAN: gd_scan<0>(big, (bf16*)(big + BIG_QKV), lds, G, (unsigned*)(ws + WS_CTL)); break;
    case T_GDPOST: gd_post((const bf16*)(big + BIG_QKV), (const bf16*)(big + BIG_Z), P.in[25], A2, G); break;
    default: break;
    }
    return type;
}

__global__ void __launch_bounds__(NTHR, 2) mega_fwd(Params P) {
    extern __shared__ __attribute__((aligned(16))) unsigned char lds[];
    const int G = gridDim.x;
#if MK_MULTI
    (void)run_phase(P.ph_lo, P, lds, G);
#else
    cg::grid_group grid = cg::this_grid();
    volatile LAS unsigned* misc = (volatile LAS unsigned*)((LAS unsigned char*)lds + LDS_MISC);
    if (threadIdx.x < 4) misc[threadIdx.x] = (threadIdx.x < 2) ? 0u : 0xffffffffu;
    __syncthreads();
    if (blockIdx.x == 0) for (int i = threadIdx.x; i < (int)(CTL_BYTES / 4); i += NTHR) __hip_atomic_store((unsigned*)(P.ws + WS_CTL) + i, 0u, __ATOMIC_RELAXED, __HIP_MEMORY_SCOPE_AGENT);
    grid.sync();
    XcdBarrier bar = xcd_barrier_post((unsigned*)(P.ws + WS_CTL), misc);
    for (int ph = P.ph_lo; ph < P.ph_hi; ++ph) {
        const int ty = run_phase(ph, P, lds, G);
#if DUP_MASK
        if ((DUP_MASK >> ty) & 1) { xcd_barrier(bar); run_phase(ph, P, lds, G); }
#endif
#if 0
#endif
#if DUP_FFT
        if (ty == T_HYFFT) { xcd_barrier(bar); hy_fft<false>((const float*)(P.ws + WS_BIG + BIG_HT), P.in[18], (unsigned*)(P.ws + WS_BIG + BIG_ZT), (const f32x2*)(P.ws + WS_TW), lds, G); }
#endif
#if DUP_SCANVAR
        if (ty == T_GDSCAN) { xcd_barrier(bar); gd_scan<DUP_SCANVAR>(P.ws + WS_BIG, (bf16*)(P.ws + WS_BIG + BIG_QKV), lds, G, (unsigned*)(P.ws + WS_CTL)); }
#endif
#if DUP_BAR
        xcd_barrier(bar);
#endif
        if (ph + 1 < P.ph_hi) xcd_barrier(bar);
    }
#endif
}

extern "C" void kernel_launch(void* const* d_in, const int* in_sizes, int n_in, void* d_out, int out_size, void* d_ws, size_t ws_size, hipStream_t stream) {
    static int grid = 0;
    if (grid == 0) {
        if (n_in != 27 || out_size != M * D || ws_size < WS_END) { fprintf(stderr, "kernel_launch: unexpected shapes (n_in %d out %d ws %zu, need %zu)\n", n_in, out_size, ws_size, (size_t)WS_END); grid = -1; return; }
        int dev = 0, cus = 0, per_cu = 0;
        (void)hipGetDevice(&dev); (void)hipDeviceGetAttribute(&cus, hipDeviceAttributeMultiprocessorCount, dev);
        if (hipFuncSetAttribute((const void*)mega_fwd, hipFuncAttributeMaxDynamicSharedMemorySize, LDS_BYTES) != hipSuccess) { fprintf(stderr, "kernel_launch: hipFuncSetAttribute failed\n"); grid = -1; return; }
        if (hipOccupancyMaxActiveBlocksPerMultiprocessor(&per_cu, (const void*)mega_fwd, NTHR, LDS_BYTES) != hipSuccess || per_cu < 1) { fprintf(stderr, "kernel_launch: occupancy query says %d\n", per_cu); per_cu = 1; }
        (void)hipGetLastError();
        grid = cus > 0 ? cus : 256;
    }
    if (grid < 0) return;
    Params p{};
    for (int i = 0; i < 27; ++i) p.in[i] = (const float*)d_in[i];
    p.out = (float*)d_out; p.ws = (unsigned char*)d_ws;
#if MK_MULTI
    for (int ph = 0; ph < N_PHASES; ++ph) { p.ph_lo = ph; p.ph_hi = ph + 1; hipLaunchKernelGGL(mega_fwd, dim3(grid), dim3(NTHR), LDS_BYTES, stream, p); }
#else
    p.ph_lo = 0; p.ph_hi = N_PHASES;
    void* args[] = {&p};
    hipError_t e = hipLaunchCooperativeKernel((const void*)mega_fwd, dim3(grid), dim3(NTHR), args, LDS_BYTES, stream);
    if (e != hipSuccess) fprintf(stderr, "cooperative launch failed: %s (grid %d)\n", hipGetErrorString(e), grid);
#endif
}
```
